# Optimizing an MI355X kernel written in HIP

```python
import jax, jax.numpy as jnp
from jax import lax
import numpy as np

D_MODEL = 1024
BATCH = 8
SEQ = 8192
DEPTH = 2

N_A = DEPTH // 2
N_B = DEPTH - N_A
N_HEADS = 16
HEAD_DIM = D_MODEL // N_HEADS
D_FF = 2816
POOL_WINDOWS = (2, 4, 8, 16)
N_POOL_GROUPS = len(POOL_WINDOWS)
GROUP_W = D_MODEL // N_POOL_GROUPS
Q_BLOCK = 128
RMS_EPS = 1e-6
FFN_RES_WEIGHT = 0.5

kernel_name = "yoco_pool_stickbreak_macaron"


def rms_norm(x, g):
    xf = x.astype(jnp.float32)
    y = xf * lax.rsqrt(jnp.mean(xf * xf, axis=-1, keepdims=True) + RMS_EPS)
    return (y * g.astype(jnp.float32)).astype(x.dtype)


def swiglu(x, w_in, w_out):
    gate, up = jnp.split(x @ w_in, 2, axis=-1)
    return (jax.nn.silu(gate) * up) @ w_out


def pool_mixer(x, w_groups, scale):
    B, S, D = x.shape
    xf = x.astype(jnp.float32)
    cs = jnp.cumsum(xf, axis=1)
    pos = jnp.arange(S)
    outs = []
    for g, w in enumerate(POOL_WINDOWS):
        sl = slice(g * GROUP_W, (g + 1) * GROUP_W)
        c = cs[..., sl]
        prev = jnp.pad(c, ((0, 0), (w, 0), (0, 0)))[:, :S]
        cnt = jnp.minimum(pos + 1, w).astype(jnp.float32)[None, :, None]
        outs.append((c - prev) / cnt - xf[..., sl])
    p = jnp.stack(outs, axis=2).astype(x.dtype)
    y = jnp.einsum('bsgc,gcd->bsgd', p, w_groups).reshape(B, S, D)
    return y * scale


def stick_breaking_attention(q, k, v):
    B, H, S, hd = q.shape
    nb = S // Q_BLOCK
    scale = hd ** -0.5
    q_blocks = q.reshape(B, H, nb, Q_BLOCK, hd).transpose(2, 0, 1, 3, 4)
    idx = jnp.arange(Q_BLOCK)

    def per_query_block(args):
        i, qi = args
        qi = qi.astype(jnp.float32) * scale
        q_pos = i * Q_BLOCK + idx

        def body(step, carry):
            o, surv = carry
            j = i - step
            kj = lax.dynamic_slice_in_dim(k, j * Q_BLOCK, Q_BLOCK, axis=2).astype(jnp.float32)
            vj = lax.dynamic_slice_in_dim(v, j * Q_BLOCK, Q_BLOCK, axis=2).astype(jnp.float32)
            z = jnp.einsum('bhqd,bhkd->bhqk', qi, kj)
            k_pos = j * Q_BLOCK + idx
            mask = k_pos[None, :] < q_pos[:, None]
            lneg = jnp.where(mask, jax.nn.log_sigmoid(-z), 0.0)
            csum = jnp.cumsum(lneg, axis=-1)
            row = csum[..., -1]
            suffix = row[..., None] - csum + surv[..., None]
            a = jnp.where(mask, jnp.exp(jax.nn.log_sigmoid(z) + suffix), 0.0)
            o = o + jnp.einsum('bhqk,bhkd->bhqd', a, vj)
            return o, surv + row

        o0 = jnp.zeros((B, H, Q_BLOCK, hd), jnp.float32)
        s0 = jnp.zeros((B, H, Q_BLOCK), jnp.float32)
        o, _ = lax.fori_loop(0, i + 1, body, (o0, s0))
        return o.astype(v.dtype)

    out = lax.map(per_query_block, (jnp.arange(nb), q_blocks))
    return out.transpose(1, 2, 0, 3, 4).reshape(B, H, S, hd)


def setup_inputs(seed: int = 0) -> dict:
    key = jax.random.key(seed)
    ks = jax.random.split(key, 20)
    f32 = jnp.float32
    D, F = D_MODEL, D_FF

    def nrm(k, shape, fan_in):
        return jax.random.normal(k, shape, f32) * (fan_in ** -0.5)

    def gain(k, shape):
        return 1.0 + 0.02 * jax.random.normal(k, shape, f32)

    return {
        "x": jax.random.normal(ks[0], (BATCH, SEQ, D), f32),
        "ffn1_norm": gain(ks[1], (DEPTH, D)),
        "ffn1_w_in": nrm(ks[2], (DEPTH, D, 2 * F), D),
        "ffn1_w_out": nrm(ks[3], (DEPTH, F, D), F),
        "ffn2_norm": gain(ks[4], (DEPTH, D)),
        "ffn2_w_in": nrm(ks[5], (DEPTH, D, 2 * F), D),
        "ffn2_w_out": nrm(ks[6], (DEPTH, F, D), F),
        "pool_norm": gain(ks[7], (N_A, D)),
        "pool_w": nrm(ks[8], (N_A, N_POOL_GROUPS, GROUP_W, GROUP_W), GROUP_W),
        "pool_scale": gain(ks[9], (N_A, D)),
        "kv_norm": gain(ks[10], (D,)),
        "w_kv": nrm(ks[11], (D, 2 * D), D),
        "k_gain": gain(ks[12], (HEAD_DIM,)),
        "attn_norm": gain(ks[13], (N_B, D)),
        "w_q": nrm(ks[14], (N_B, D, D), D),
        "q_gain": gain(ks[15], (N_B, HEAD_DIM)),
        "w_o": nrm(ks[16], (N_B, D, D), D),
    }


def reference(x, ffn1_norm, ffn1_w_in, ffn1_w_out, ffn2_norm, ffn2_w_in, ffn2_w_out,
              pool_norm, pool_w, pool_scale, kv_norm, w_kv, k_gain,
              attn_norm, w_q, q_gain, w_o):
    B, S, D = x.shape
    h = x
    k = None
    v = None
    for l in range(DEPTH):
        h = h + FFN_RES_WEIGHT * swiglu(rms_norm(h, ffn1_norm[l]), ffn1_w_in[l], ffn1_w_out[l])
        if l < N_A:
            h = h + pool_mixer(rms_norm(h, pool_norm[l]), pool_w[l], pool_scale[l])
        else:
            b = l - N_A
            q = (rms_norm(h, attn_norm[b]) @ w_q[b]).reshape(B, S, N_HEADS, HEAD_DIM)
            q = rms_norm(q, q_gain[b]).transpose(0, 2, 1, 3)
            o = stick_breaking_attention(q, k, v)
            h = h + o.transpose(0, 2, 1, 3).reshape(B, S, D) @ w_o[b]
        h = h + FFN_RES_WEIGHT * swiglu(rms_norm(h, ffn2_norm[l]), ffn2_w_in[l], ffn2_w_out[l])
        if l == N_A - 1:
            k_flat, v_flat = jnp.split(rms_norm(h, kv_norm) @ w_kv, 2, axis=-1)
            k = rms_norm(k_flat.reshape(B, S, N_HEADS, HEAD_DIM), k_gain).transpose(0, 2, 1, 3)
            v = v_flat.reshape(B, S, N_HEADS, HEAD_DIM).transpose(0, 2, 1, 3)
    return h
```

```cpp
#include <hip/hip_runtime.h>
#include <hip/hip_cooperative_groups.h>
#include <cstdio>
#include <cstdint>
namespace cg = cooperative_groups;

#ifndef MK_SINGLE
#define MK_SINGLE 1
#endif

#ifndef MK_REP
#define MK_REP 99
#endif
#define LAS __attribute__((address_space(3)))
typedef unsigned short bf16_t;
typedef short bf16x8 __attribute__((ext_vector_type(8)));
typedef float f32x4 __attribute__((ext_vector_type(4)));
typedef float f32x16 __attribute__((ext_vector_type(16)));
typedef unsigned u32x4 __attribute__((ext_vector_type(4)));
typedef unsigned u32x2 __attribute__((ext_vector_type(2)));
typedef float f32x2_t __attribute__((ext_vector_type(2)));
typedef __bf16 bf16x2_t __attribute__((ext_vector_type(2)));

constexpr int DM = 1024, NB = 8, SEQ = 8192, M = NB * SEQ, NH = 16, HD = 64, FF = 2816, NIN = 2 * FF;
constexpr float EPS = 1e-6f;
constexpr float LOG2E = 1.4426950408889634f, LN2 = 0.6931471805599453f;

constexpr size_t MiB = 1u << 20;
constexpr size_t WS_SSA = 0, WS_SSB = 1 * MiB;
constexpr size_t WS_BAR = 2 * MiB;
constexpr size_t WS_WIN = 4 * MiB, WIN_BYTES = (size_t)NIN * DM * 2;
constexpr size_t WS_WOUT = 48 * MiB, WOUT_BYTES = (size_t)DM * FF * 2;
constexpr size_t WS_WK = 70 * MiB, WS_WV = 72 * MiB, WS_WQ = 74 * MiB, WS_WO = 76 * MiB, WS_WP = 78 * MiB;
constexpr size_t WS_HBA = 80 * MiB, WS_HBB = 208 * MiB;
constexpr size_t WS_HID = 336 * MiB;
constexpr size_t WS_K = 688 * MiB, WS_VT = 816 * MiB, WS_END = 944 * MiB;
static_assert(WS_WIN + 4 * WIN_BYTES <= WS_WOUT && WS_WOUT + 4 * WOUT_BYTES <= WS_WK, "ws map");
static_assert(WS_HID + (size_t)M * FF * 2 <= WS_K, "ws map");

constexpr int RING_BYTES = 131072, SCR_OFF = RING_BYTES, SS_OFF = RING_BYTES + 8192, LDS_BYTES = RING_BYTES + 16384;

__device__ __forceinline__ unsigned cvtpk(float lo, float hi) { f32x2_t v = {lo, hi}; bf16x2_t b = __builtin_convertvector(v, bf16x2_t); return __builtin_bit_cast(unsigned, b); }
__device__ __forceinline__ float rstd_from(const f32x4 s) { float a = s[0] + s[1], b = s[2] + s[3]; asm volatile("" : "+v"(a), "+v"(b));
    return __builtin_amdgcn_rsqf((a + b) * (1.0f / DM) + EPS); }

__device__ __forceinline__ f32x4 zero4() {
    typedef unsigned long long u64x2 __attribute__((ext_vector_type(2)));
    unsigned long long a, b; asm volatile("v_mov_b64 %0, 0\n\tv_mov_b64 %1, 0" : "=v"(a), "=v"(b));
    u64x2 v = {a, b}; return __builtin_bit_cast(f32x4, v);
}
namespace pg8 {
constexpr int BM = 256, BK = 64, HALF = 128, HTB = HALF * BK * 2, NXCD = 8, WGM = 8;
__device__ __forceinline__ int lds_byte(int r, int c) { const int st = (r >> 4) * 2 + (c >> 5), rr = r & 15, cc = c & 31, ob = rr * 64 + cc * 2; return st * 1024 + (ob ^ (((ob >> 9) & 1) << 5)); }
__device__ __forceinline__ void stage_rc(int b, int& R, int& C) { const int st = b / 1024, sb = b % 1024, swz = sb ^ (((sb >> 9) & 1) << 5); R = (st >> 1) * 16 + swz / 64; C = (st & 1) * 32 + (swz % 64) / 2; }
__device__ __forceinline__ int perm32(int rho) { const int n = rho >> 4, i = rho & 15; return 8 * (i >> 2) + 4 * n + (i & 3); }

struct Unit { int pm, pn; };
struct Gemm { const bf16_t* A; const bf16_t* Bt; int lda, ldb, K, a_pn_bytes; };

struct StaticOrder {
    int nM, nN, nwg, G, c, mode = 0;
    __device__ __forceinline__ void init(int nM_, int nN_, int G_, int c_) { nM = nM_; nN = nN_; nwg = nM * nN; G = G_; c = c_; }
    __device__ __forceinline__ bool next(int i, Unit& u) const {
        const long L = (long)i * G + c; if (L >= nwg) return false;
        int wgid = (int)L;
        if (mode == 1) {
            const int xcd = wgid & 7, p = wgid >> 3; int pml, pn;
            if (p < 640) { const int j = p >> 7, rem = p & 127, b = rem >> 5, k = rem & 31; pml = 8 * b + (k & 7); pn = 4 * j + (k >> 3); }
            else { const int pp = p - 640, b = pp >> 4, k = pp & 15; pml = 8 * b + (k & 7); pn = 20 + (k >> 3); }
            u.pm = 32 * xcd + pml; u.pn = pn; return true;
        } { const int q = nwg / NXCD, r = nwg % NXCD, xcd = wgid % NXCD, off = wgid / NXCD; wgid = (xcd < r ? xcd * (q + 1) : r * (q + 1) + (xcd - r) * q) + off; }
        const int nig = WGM * nN, gid = wgid / nig, fm = gid * WGM, gsz = (nM - fm) < WGM ? (nM - fm) : WGM;
        u.pm = fm + ((wgid % nig) % gsz); u.pn = (wgid % nig) / gsz; return true;
    }
};


struct EpiSwiGLU {
    static constexpr int SS_STAGE = 1;
    bf16_t* H; const float* ss4;
    __device__ __forceinline__ void operator()(const f32x4 (&acc)[2][2][4][2], const Unit& u, int wr, int wc, int fr, int fq, int tid, LAS float* scr, int sbuf) const {
        const int row0 = u.pm * BM + wr * 64 + fr, col0 = u.pn * 128 + wc * 32 + 8 * fq;
        f32x4 sv[2][4];
#pragma unroll
        for (int ai = 0; ai < 2; ++ai)
#pragma unroll
            for (int m = 0; m < 4; ++m) sv[ai][m] = *(const LAS f32x4*)((const LAS unsigned char*)scr + 8192 + sbuf * 4096 + (ai * HALF + wr * 64 + m * 16 + fr) * 16);
#pragma unroll
        for (int ai = 0; ai < 2; ++ai)
#pragma unroll
            for (int m = 0; m < 4; ++m) {
                const int row = row0 + ai * HALF + m * 16;
                const float rs = rstd_from(sv[ai][m]), rs2 = rs * (-LOG2E), irsq = __builtin_amdgcn_rcpf(rs * rs);
                float o[8];
#pragma unroll
                for (int n = 0; n < 2; ++n)
#pragma unroll
                    for (int p = 0; p < 2; ++p) {
                        const f32x2_t ag = {acc[ai][0][m][n][2 * p], acc[ai][0][m][n][2 * p + 1]}, au = {acc[ai][1][m][n][2 * p], acc[ai][1][m][n][2 * p + 1]};
                        const f32x2_t t = ag * rs2;
                        f32x2_t d; d.x = __builtin_amdgcn_exp2f(t.x); d.y = __builtin_amdgcn_exp2f(t.y); d = d * irsq + irsq;
                        f32x2_t r; r.x = __builtin_amdgcn_rcpf(d.x); r.y = __builtin_amdgcn_rcpf(d.y);
                        const f32x2_t res = (ag * au) * r;
                        o[n * 4 + 2 * p] = res.x; o[n * 4 + 2 * p + 1] = res.y;
                    }
                u32x4 w; w.x = cvtpk(o[0], o[1]); w.y = cvtpk(o[2], o[3]); w.z = cvtpk(o[4], o[5]); w.w = cvtpk(o[6], o[7]);
                *(u32x4*)(H + (size_t)row * FF + col0) = w;
            }
    }
};

__device__ __forceinline__ void unpack8v(const u32x4 p, f32x4& a, f32x4& b) {
    a[0] = __builtin_bit_cast(float, p[0] << 16); a[1] = __builtin_bit_cast(float, p[0] & 0xffff0000u); a[2] = __builtin_bit_cast(float, p[1] << 16); a[3] = __builtin_bit_cast(float, p[1] & 0xffff0000u);
    b[0] = __builtin_bit_cast(float, p[2] << 16); b[1] = __builtin_bit_cast(float, p[2] & 0xffff0000u); b[2] = __builtin_bit_cast(float, p[3] << 16); b[3] = __builtin_bit_cast(float, p[3] & 0xffff0000u);
}
struct EpiRes {
    static constexpr int SS_STAGE = 0;
    const bf16_t* res; bf16_t* outb; float* outf; float* ss4; int fin;
    __device__ __forceinline__ void operator()(const f32x4 (&acc)[2][2][4][2], const Unit& u, int wr, int wc, int fr, int fq, int tid, LAS float* scr, int sbuf) const {
        const int row0 = u.pm * BM + wr * 64 + fr, col0 = u.pn * BM + wc * 32 + 8 * fq;
        u32x4 rv[2][4][2];
#pragma unroll
        for (int ai = 0; ai < 2; ++ai)
#pragma unroll
            for (int m = 0; m < 4; ++m)
#pragma unroll
                for (int bj = 0; bj < 2; ++bj) rv[ai][m][bj] = *(const u32x4*)(res + (size_t)(row0 + ai * HALF + m * 16) * DM + col0 + bj * HALF);
#pragma unroll
        for (int ai = 0; ai < 2; ++ai) {
#pragma unroll
            for (int m = 0; m < 4; ++m) {
                const int row = row0 + ai * HALF + m * 16; float s = 0.f;
#pragma unroll
                for (int bj = 0; bj < 2; ++bj) {
                    const size_t off = (size_t)row * DM + col0 + bj * HALF;
                    f32x4 r0, r1; unpack8v(rv[ai][m][bj], r0, r1);
                    const f32x4 v0 = r0 + acc[ai][bj][m][0], v1 = r1 + acc[ai][bj][m][1];
                    if (fin) { *(f32x4*)(outf + off) = v0; *(f32x4*)(outf + off + 4) = v1; }
                    else {
                        u32x4 w; w.x = cvtpk(v0[0], v0[1]); w.y = cvtpk(v0[2], v0[3]); w.z = cvtpk(v1[0], v1[1]); w.w = cvtpk(v1[2], v1[3]);
                        *(u32x4*)(outb + off) = w;
                        s += (v0[0] * v0[0] + v0[1] * v0[1]) + (v0[2] * v0[2] + v0[3] * v0[3]) + (v1[0] * v1[0] + v1[1] * v1[1]) + (v1[2] * v1[2] + v1[3] * v1[3]);
                    }
                }
                if (!fin) { s += __shfl_xor(s, 16); s += __shfl_xor(s, 32);
                    if (fq == 0) scr[(ai * HALF + wr * 64 + m * 16 + fr) * 4 + wc] = s; }
            }
        }
        if (!fin) {
            asm volatile("s_waitcnt lgkmcnt(0)" ::: "memory"); __builtin_amdgcn_s_barrier(); asm volatile("" ::: "memory");
            if (tid < 256) { const f32x4 p = *(const LAS f32x4*)(scr + tid * 4); ss4[(size_t)(u.pm * BM + tid) * 4 + u.pn] = (p[0] + p[1]) + (p[2] + p[3]); }
        }
    }
};

struct EpiHeadNorm {
    static constexpr int SS_STAGE = 1;
    bf16_t* O; const float* ss4; const float* gain; float oscale;
    __device__ __forceinline__ void operator()(const f32x4 (&acc)[2][2][4][2], const Unit& u, int wr, int wc, int fr, int fq, int tid, LAS float* scr, int sbuf) const {
        const int row0 = u.pm * BM + wr * 64 + fr, colh = (u.pn * 4 + wc) * 64 + 8 * fq;
        f32x4 gv[2][2];
#pragma unroll
        for (int bj = 0; bj < 2; ++bj)
#pragma unroll
            for (int n = 0; n < 2; ++n) gv[bj][n] = *(const f32x4*)(gain + 32 * bj + 8 * fq + 4 * n);
        f32x4 sv[2][4];
#pragma unroll
        for (int ai = 0; ai < 2; ++ai)
#pragma unroll
            for (int m = 0; m < 4; ++m) sv[ai][m] = *(const LAS f32x4*)((const LAS unsigned char*)scr + 8192 + sbuf * 4096 + (ai * HALF + wr * 64 + m * 16 + fr) * 16);
#pragma unroll
        for (int ai = 0; ai < 2; ++ai)
#pragma unroll
            for (int m = 0; m < 4; ++m) {
                const int row = row0 + ai * HALF + m * 16;
                const float rs = rstd_from(sv[ai][m]);
                f32x4 v[2][2]; float s = 0.f;
#pragma unroll
                for (int bj = 0; bj < 2; ++bj)
#pragma unroll
                    for (int n = 0; n < 2; ++n) { v[bj][n] = acc[ai][bj][m][n] * rs; const f32x4 x = v[bj][n]; s += (x[0] * x[0] + x[1] * x[1]) + (x[2] * x[2] + x[3] * x[3]); }
                s += __shfl_xor(s, 16); s += __shfl_xor(s, 32);
                const float hr = __builtin_amdgcn_rsqf(s * (1.0f / HD) + EPS) * oscale;
#pragma unroll
                for (int bj = 0; bj < 2; ++bj) {
                    const f32x4 a = v[bj][0] * gv[bj][0] * hr, b = v[bj][1] * gv[bj][1] * hr;
                    u32x4 w; w.x = cvtpk(a[0], a[1]); w.y = cvtpk(a[2], a[3]); w.z = cvtpk(b[0], b[1]); w.w = cvtpk(b[2], b[3]);
                    *(u32x4*)(O + (size_t)row * DM + colh + 32 * bj) = w;
                }
            }
    }
};

struct EpiVT {
    static constexpr int SS_STAGE = 2;
    bf16_t* VT; const float* ss4;
    __device__ __forceinline__ void operator()(const f32x4 (&acc)[2][2][4][2], const Unit& u, int wr, int wc, int fr, int fq, int tid, LAS float* scr, int sbuf) const {
        const int row0 = u.pm * BM + wr * 64 + fr, col0 = u.pn * BM + wc * 32 + 8 * fq;
        float rs[2][8];
#pragma unroll
        for (int bj = 0; bj < 2; ++bj)
#pragma unroll
            for (int j = 0; j < 8; ++j) rs[bj][j] = rstd_from(*(const LAS f32x4*)((const LAS unsigned char*)scr + 8192 + sbuf * 4096 + (bj * HALF + wc * 32 + 8 * fq + j) * 16));
#pragma unroll
        for (int ai = 0; ai < 2; ++ai)
#pragma unroll
            for (int m = 0; m < 4; ++m) {
                const int row = row0 + ai * HALF + m * 16;
#pragma unroll
                for (int bj = 0; bj < 2; ++bj) {
                    const f32x4 a = acc[ai][bj][m][0], b = acc[ai][bj][m][1];
                    u32x4 w; w.x = cvtpk(a[0] * rs[bj][0], a[1] * rs[bj][1]); w.y = cvtpk(a[2] * rs[bj][2], a[3] * rs[bj][3]);
                    w.z = cvtpk(b[0] * rs[bj][4], b[1] * rs[bj][5]); w.w = cvtpk(b[2] * rs[bj][6], b[3] * rs[bj][7]);
                    *(u32x4*)(VT + (size_t)row * M + col0 + bj * HALF) = w;
                }
            }
    }
};

template <class Epi>
__device__ __forceinline__ void gemm_phase(LAS unsigned char* lds, const Gemm g, const StaticOrder& S, const Epi& E, const int tid) {
    const int wid = __builtin_amdgcn_readfirstlane(tid >> 6), lane = tid & 63, wr = wid >> 2, wc = wid & 3, fr = lane & 15, fq = lane >> 4;
    const int K = g.K, nt = K / BK;
    unsigned voffA[2], voffB[2];
#pragma unroll
    for (int i = 0; i < 2; ++i) { int R, C; stage_rc(tid * 16 + i * 8192, R, C); const int Rb = (R & ~31) + perm32(R & 31);
        voffA[i] = (unsigned)(R * g.lda + C) * 2u; voffB[i] = (unsigned)(Rb * g.ldb + C) * 2u; }
    const size_t kstep = (size_t)(BK * 2);
    const size_t hstepA = (size_t)HALF * g.lda * 2, hstepB = (size_t)HALF * g.ldb * 2;
    const size_t tstepA = 2 * hstepA, tstepB = 2 * hstepB;
    const unsigned ldsw = (unsigned)wid * 1024u;
    const int aoff = lds_byte(wr * 64 + fr, fq * 8), boff = lds_byte(wc * 32 + fr, fq * 8);
#define PG8_SA(b, h) (((b) * 2 + (h)) * HTB)
#define PG8_SB(b, h) ((4 + (b) * 2 + (h)) * HTB)
#define PG8_STAGE(bufoff, gbase, voff) do { _Pragma("unroll") for (int _i = 0; _i < 2; ++_i) \
        __builtin_amdgcn_global_load_lds((const unsigned*)((const char*)(gbase) + (voff)[_i]), (LAS unsigned*)(lds + (bufoff) + ldsw + _i * 8192), 16, 0, 0); } while (0)
#define PG8_LDA(dst, b, h) do { _Pragma("unroll") for (int m = 0; m < 4; ++m) _Pragma("unroll") for (int k = 0; k < 2; ++k) dst[m][k] = *(const LAS bf16x8*)(lds + PG8_SA(b, h) + aoff + m * 2048 + k * 1024); } while (0)
#define PG8_LDB(dst, b, h) do { _Pragma("unroll") for (int n = 0; n < 2; ++n) _Pragma("unroll") for (int k = 0; k < 2; ++k) dst[n][k] = *(const LAS bf16x8*)(lds + PG8_SB(b, h) + boff + n * 2048 + k * 1024); } while (0)
#define PG8_MMA(ai, bj, At, Bt) do { __builtin_amdgcn_s_setprio(1); _Pragma("unroll") for (int m = 0; m < 4; ++m) _Pragma("unroll") for (int n = 0; n < 2; ++n) _Pragma("unroll") for (int k = 0; k < 2; ++k) \
        acc[ai][bj][m][n] = __builtin_amdgcn_mfma_f32_16x16x32_bf16(Bt[n][k], At[m][k], acc[ai][bj][m][n], 0, 0, 0); __builtin_amdgcn_s_setprio(0); } while (0)
#define PG8_WAIT_V(n) asm volatile("s_waitcnt vmcnt(" #n ")" ::: "memory")
#define PG8_WAIT_L(n) asm volatile("s_waitcnt lgkmcnt(" #n ")" ::: "memory")
#define PG8_BAR __builtin_amdgcn_s_barrier()
#define PG8_SCHED __builtin_amdgcn_sched_barrier(0)
    Unit cur, nxt; int ui = 0;
    if (!S.next(0, cur)) return;
#define PG8_SS_PREFETCH(U, BUF) do { if (Epi::SS_STAGE != 0 && wid < 4) { const char* sb_ = (const char*)E.ss4 + (size_t)((Epi::SS_STAGE == 2 ? (U).pn : (U).pm) * BM + wid * 64) * 16; \
        __builtin_amdgcn_global_load_lds((const unsigned*)(sb_ + (unsigned)lane * 16u), (LAS unsigned*)(lds + SS_OFF + (BUF) * 4096 + wid * 1024), 16, 0, 0); } } while (0)
    PG8_SS_PREFETCH(cur, 0);
    f32x4 acc[2][2][4][2];
#pragma unroll
    for (int a = 0; a < 2; ++a)
#pragma unroll
        for (int b = 0; b < 2; ++b)
#pragma unroll
            for (int m = 0; m < 4; ++m)
#pragma unroll
                for (int n = 0; n < 2; ++n) acc[a][b][m][n] = zero4();
    bf16x8 At[4][2], B0[2][2], B1[2][2];
    const char* cA = (const char*)g.A + (size_t)cur.pm * tstepA + (size_t)cur.pn * g.a_pn_bytes; const char* cB = (const char*)g.Bt + (size_t)cur.pn * tstepB;
    PG8_STAGE(PG8_SB(0, 0), cB, voffB); PG8_STAGE(PG8_SB(0, 1), cB + hstepB, voffB); PG8_STAGE(PG8_SA(0, 0), cA, voffA); PG8_STAGE(PG8_SA(0, 1), cA + hstepA, voffA);
    if (wr == 1) PG8_BAR;
    PG8_WAIT_V(2); PG8_BAR;
    PG8_STAGE(PG8_SB(1, 0), cB + kstep, voffB); PG8_STAGE(PG8_SA(1, 0), cA + kstep, voffA); PG8_STAGE(PG8_SB(1, 1), cB + hstepB + kstep, voffB);
    PG8_WAIT_V(6); PG8_BAR;
    for (;;) {
        const bool has_next = S.next(ui + 1, nxt);
        const char* nA = has_next ? (const char*)g.A + (size_t)nxt.pm * tstepA + (size_t)nxt.pn * g.a_pn_bytes : cA; const char* nB = has_next ? (const char*)g.Bt + (size_t)nxt.pn * tstepB : cB;
        for (int t = 0; t < nt; t += 2) {
            const bool last = (t == nt - 2);
            const char* a1 = cA + (size_t)(t + 1) * kstep;
            const char* a2 = last ? nA : cA + (size_t)(t + 2) * kstep; const char* b2 = last ? nB : cB + (size_t)(t + 2) * kstep;
            const char* a3 = a2 + kstep; const char* b3 = b2 + kstep;
            PG8_LDB(B0, 0, 0); PG8_LDB(B1, 0, 1); PG8_SCHED; PG8_LDA(At, 0, 0); PG8_STAGE(PG8_SA(1, 1), a1 + hstepA, voffA);
            PG8_WAIT_V(8); PG8_WAIT_L(0); PG8_BAR; PG8_MMA(0, 0, At, B0); PG8_MMA(0, 1, At, B1); PG8_BAR; PG8_SCHED;
            PG8_LDA(At, 0, 1); PG8_STAGE(PG8_SB(0, 0), b2, voffB); PG8_STAGE(PG8_SB(0, 1), b2 + hstepB, voffB); PG8_STAGE(PG8_SA(0, 0), a2, voffA);
            PG8_WAIT_V(8); PG8_WAIT_L(0); PG8_BAR; PG8_MMA(1, 0, At, B0); PG8_MMA(1, 1, At, B1); PG8_BAR; PG8_SCHED;
            PG8_LDB(B0, 1, 0); PG8_LDB(B1, 1, 1); PG8_SCHED; PG8_LDA(At, 1, 0); PG8_STAGE(PG8_SA(0, 1), a2 + hstepA, voffA);
            PG8_WAIT_V(8); PG8_WAIT_L(0); PG8_BAR; PG8_MMA(0, 0, At, B0); PG8_MMA(0, 1, At, B1); PG8_BAR; PG8_SCHED;
            PG8_LDA(At, 1, 1); PG8_STAGE(PG8_SB(1, 0), b3, voffB); PG8_STAGE(PG8_SB(1, 1), b3 + hstepB, voffB); PG8_STAGE(PG8_SA(1, 0), a3, voffA);
            PG8_WAIT_V(8); PG8_WAIT_L(0); PG8_BAR; PG8_MMA(1, 0, At, B0); PG8_MMA(1, 1, At, B1); PG8_BAR; PG8_SCHED;
        }
        if (wr == 0) PG8_BAR;
        E(acc, cur, wr, wc, fr, fq, tid, (LAS float*)(lds + 131072), ui & 1);
        if (!has_next) break;
        PG8_SS_PREFETCH(nxt, (ui + 1) & 1);
#pragma unroll
        for (int a = 0; a < 2; ++a)
#pragma unroll
            for (int b = 0; b < 2; ++b)
#pragma unroll
                for (int m = 0; m < 4; ++m)
#pragma unroll
                    for (int n = 0; n < 2; ++n) acc[a][b][m][n] = zero4();
        cur = nxt; cA = nA; cB = nB; ++ui;
        if (wr == 1) PG8_BAR;
    }
    PG8_WAIT_V(0);
    PG8_BAR;
#undef PG8_SA
#undef PG8_SB
#undef PG8_STAGE
#undef PG8_LDA
#undef PG8_LDB
#undef PG8_MMA
#undef PG8_WAIT_V
#undef PG8_WAIT_L
#undef PG8_BAR
#undef PG8_SCHED
#undef PG8_SS_PREFETCH
}
}

__device__ __forceinline__ void tr_item(const float* W, int ldn, int k0, int n0, const float* gk, const float* cs, bf16_t* WT, int ldk, int drow0, LAS float* scr, int lane, float mul = 1.f) {
    const int n = lane & 31, kh = lane >> 5;
    const float csn = (cs ? cs[n0 + n] : 1.f) * mul;
    float wv[32];
#pragma unroll
    for (int i = 0; i < 32; ++i) wv[i] = W[(size_t)(k0 + 2 * i + kh) * ldn + n0 + n];
#pragma unroll
    for (int i = 0; i < 32; ++i) { const int kk = 2 * i + kh; const float gg = gk ? gk[k0 + kk] : 1.f; scr[kk * 33 + n] = wv[i] * gg * csn; }
    asm volatile("s_waitcnt lgkmcnt(0)" ::: "memory");
    const int c = lane & 7;
#pragma unroll
    for (int j = 0; j < 4; ++j) { const int nn = (lane >> 3) + 8 * j; const LAS float* s = scr + (8 * c) * 33 + nn;
        u32x4 o; o.x = cvtpk(s[0 * 33], s[1 * 33]); o.y = cvtpk(s[2 * 33], s[3 * 33]); o.z = cvtpk(s[4 * 33], s[5 * 33]); o.w = cvtpk(s[6 * 33], s[7 * 33]);
        *(u32x4*)(WT + (size_t)(drow0 + nn) * ldk + k0 + 8 * c) = o; }
    asm volatile("s_waitcnt lgkmcnt(0)" ::: "memory");
}

struct Args { const float* in[17]; float* out; unsigned char* ws; int st_lo, st_hi; };

typedef const __attribute__((address_space(4))) Args* KArgs;
__device__ __forceinline__ KArgs get_args() { const __attribute__((address_space(4))) void* p = (const __attribute__((address_space(4))) void*)__builtin_amdgcn_kernarg_segment_ptr(); asm volatile("" : "+s"(p)); return (KArgs)p; }
__device__ __forceinline__ void prep_phase(KArgs ap, LAS unsigned char* lds, int gw, int NGW, int wave, int lane) {
    LAS float* scr = (LAS float*)(lds + wave * 16384);
    unsigned char* ws = ap->ws;
    constexpr int I_IN = (DM / 64) * (NIN / 32);
    constexpr int I_OUT = (FF / 64) * (DM / 32);
    constexpr int I_SQ = (DM / 64) * (DM / 32);
    constexpr int I_P = 4 * (256 / 64) * (256 / 32);
    constexpr int NITEMS = 4 * I_IN + 4 * I_OUT + 4 * I_SQ + I_P;
    for (int it = gw; it < NITEMS; it += NGW) {
        int r = it;
        if (r < 4 * I_IN) {
            const int f = r / I_IN; r -= f * I_IN; const int l = f >> 1;
            const float* W = ap->in[(f & 1) ? 5 : 2] + (size_t)l * DM * NIN; const float* gk = ap->in[(f & 1) ? 4 : 1] + l * DM;
            const int nblk = NIN / 32, kb = r / nblk, db = r % nblk, R = 32 * db, pn = R >> 8, bj = (R >> 7) & 1, j = R & 127;
            tr_item(W, NIN, 64 * kb, bj * FF + 128 * pn + j, gk, nullptr, (bf16_t*)(ws + WS_WIN + f * WIN_BYTES), DM, R, scr, lane);
            continue;
        }
        r -= 4 * I_IN;
        if (r < 4 * I_OUT) {
            const int f = r / I_OUT; r -= f * I_OUT; const int l = f >> 1;
            const float* W = ap->in[(f & 1) ? 6 : 3] + (size_t)l * FF * DM;
            const int nblk = DM / 32, kb = r / nblk, db = r % nblk;
            tr_item(W, DM, 64 * kb, 32 * db, nullptr, nullptr, (bf16_t*)(ws + WS_WOUT + f * WOUT_BYTES), FF, 32 * db, scr, lane, 0.5f);
            continue;
        }
        r -= 4 * I_OUT;
        if (r < 4 * I_SQ) {
            const int q = r / I_SQ; r -= q * I_SQ; const int kb = r / 32, db = r % 32, R = 32 * db;
            const int srcp = (R & ~255) + 64 * ((R >> 5) & 3) + 32 * ((R >> 7) & 1);
            if (q == 0)      tr_item(ap->in[11], 2 * DM, 64 * kb, srcp, ap->in[10], nullptr, (bf16_t*)(ws + WS_WK), DM, R, scr, lane);
            else if (q == 1) tr_item(ap->in[11], 2 * DM, 64 * kb, DM + R, ap->in[10], nullptr, (bf16_t*)(ws + WS_WV), DM, R, scr, lane);
            else if (q == 2) tr_item(ap->in[14], DM, 64 * kb, srcp, ap->in[13], nullptr, (bf16_t*)(ws + WS_WQ), DM, R, scr, lane);
            else             tr_item(ap->in[16], DM, 64 * kb, R, nullptr, nullptr, (bf16_t*)(ws + WS_WO), DM, R, scr, lane);
            continue;
        }
        r -= 4 * I_SQ;
        { const int gI = r / 32; r -= gI * 32; const int kb = r / 8, db = r % 8;
          tr_item(ap->in[8] + (size_t)gI * 65536, 256, 64 * kb, 32 * db, ap->in[7] + gI * 256, ap->in[9] + gI * 256, (bf16_t*)(ws + WS_WP) + (size_t)gI * 65536, 256, 32 * db, scr, lane); }
    }
    const float* x = ap->in[0]; bf16_t* xb = (bf16_t*)(ws + WS_HBA); float* ss = (float*)(ws + WS_SSA);
    for (int m0 = gw * 4; m0 < M; m0 += NGW * 4) {
        f32x4 v[4][4]; float sq[4];
#pragma unroll
        for (int rr = 0; rr < 4; ++rr) { const f32x4* xr = (const f32x4*)(x + (size_t)(m0 + rr) * DM) + lane;
#pragma unroll
            for (int j = 0; j < 4; ++j) v[rr][j] = xr[64 * j]; }
#pragma unroll
        for (int rr = 0; rr < 4; ++rr) { float s = 0.f;
#pragma unroll
            for (int j = 0; j < 4; ++j) s += (v[rr][j][0] * v[rr][j][0] + v[rr][j][1] * v[rr][j][1]) + (v[rr][j][2] * v[rr][j][2] + v[rr][j][3] * v[rr][j][3]);
            sq[rr] = s; }
#pragma unroll
        for (int o = 1; o < 64; o <<= 1) {
#pragma unroll
            for (int rr = 0; rr < 4; ++rr) sq[rr] += __shfl_xor(sq[rr], o); }
#pragma unroll
        for (int rr = 0; rr < 4; ++rr) { u32x2* o8 = (u32x2*)(xb + (size_t)(m0 + rr) * DM) + lane;
#pragma unroll
            for (int j = 0; j < 4; ++j) { u32x2 w; w.x = cvtpk(v[rr][j][0], v[rr][j][1]); w.y = cvtpk(v[rr][j][2], v[rr][j][3]); o8[64 * j] = w; }
            if (lane == 0) *(f32x4*)(ss + (size_t)(m0 + rr) * 4) = (f32x4){sq[rr], 0.f, 0.f, 0.f}; }
    }
}

__device__ __forceinline__ void unpack8(const u32x4 p, float (&f)[8]) {
#pragma unroll
    for (int i = 0; i < 4; ++i) { f[2 * i] = __builtin_bit_cast(float, p[i] << 16); f[2 * i + 1] = __builtin_bit_cast(float, p[i] & 0xffff0000u); }
}
__device__ __forceinline__ void pool_in_phase(const bf16_t* __restrict__ hb, const float* __restrict__ ss4, bf16_t* __restrict__ P, int gw, int NGW, int lane) {
    const int NITEMS = (M / 32) * 2;
    for (int it = gw; it < NITEMS; it += NGW) {
        const int chunk = it >> 1, strip = it & 1, t0 = chunk * 32, pos0 = t0 & (SEQ - 1);
        float rs = 0.f;
        if (lane < 48 && pos0 + lane - 16 >= 0) rs = rstd_from(*(const f32x4*)(ss4 + (size_t)(t0 - 16 + lane) * 4));
        const int c0 = strip * 512 + lane * 8, w = 2 << (c0 >> 8);
        float S[8];
#pragma unroll
        for (int e = 0; e < 8; ++e) S[e] = 0.f;
#pragma unroll
        for (int j = 1; j <= 16; ++j) {
            const float rj = __shfl(rs, 16 - j);
            if (j <= w && pos0 - j >= 0) { float f[8]; unpack8(*(const u32x4*)(hb + (size_t)(t0 - j) * DM + c0), f);
#pragma unroll
                for (int e = 0; e < 8; ++e) S[e] += f[e] * rj; }
        }
        for (int ib = 0; ib < 4; ++ib) {
            u32x4 xn[8], xo[8];
#pragma unroll
            for (int k = 0; k < 8; ++k) { const int i = ib * 8 + k, t = t0 + i; const bool has = (pos0 + i >= w);
                xn[k] = *(const u32x4*)(hb + (size_t)t * DM + c0); xo[k] = *(const u32x4*)(hb + (size_t)(has ? t - w : t) * DM + c0); }
#pragma unroll
            for (int k = 0; k < 8; ++k) {
                const int i = ib * 8 + k, t = t0 + i, pos = pos0 + i;
                const float rt = __shfl(rs, 16 + i); float ro = __shfl(rs, 16 + i - w); ro = (pos >= w) ? ro : 0.f;
                float xs[8], f[8]; unpack8(xn[k], xs); unpack8(xo[k], f);
#pragma unroll
                for (int e = 0; e < 8; ++e) { xs[e] *= rt; S[e] += xs[e]; S[e] -= f[e] * ro; }
                const int cnt = (pos + 1 < w) ? pos + 1 : w; const float ic = 1.0f / (float)cnt;
                u32x4 o; o.x = cvtpk(S[0] * ic - xs[0], S[1] * ic - xs[1]); o.y = cvtpk(S[2] * ic - xs[2], S[3] * ic - xs[3]);
                o.z = cvtpk(S[4] * ic - xs[4], S[5] * ic - xs[5]); o.w = cvtpk(S[6] * ic - xs[6], S[7] * ic - xs[7]);
                *(u32x4*)(P + (size_t)t * DM + c0) = o;
            }
        }
    }
}

__device__ __forceinline__ float xchg32(float v, int hi) {
    const unsigned u = __builtin_bit_cast(unsigned, v);
    const auto r = __builtin_amdgcn_permlane32_swap(u, u, false, false);
    return __builtin_bit_cast(float, hi ? r[0] : r[1]);
}
template <bool MASK>
__device__ __forceinline__ void sb_tile(const f32x16& Sx, float& carry, int hi, int qlim, bf16x8 (&pf)[2]) {
    float L[16];
#pragma unroll
    for (int r = 0; r < 16; ++r) {
        const float z = Sx[r];
        const float e = __builtin_amdgcn_exp2f(-__builtin_fabsf(z));
        const float sp = __builtin_fmaf(0.5f, z, __builtin_fmaf(0.5f, __builtin_fabsf(z), __builtin_amdgcn_logf(1.0f + e)));
        if (MASK) { const int kk = 16 * (r >> 3) + 8 * hi + (r & 7); L[r] = (kk < qlim) ? -sp : 0.f; } else L[r] = -sp;
    }
    float suf[16];
    suf[7] = L[7]; suf[15] = L[15];
#pragma unroll
    for (int r = 6; r >= 0; --r) { suf[r] = L[r] + suf[r + 1]; suf[8 + r] = L[8 + r] + suf[9 + r]; }
    const float T0 = suf[0], T1 = suf[8];
    const float T0p = xchg32(T0, hi), T1p = xchg32(T1, hi);
    const float offB = carry + (hi == 0 ? T1p : 0.f);
    const float offA = carry + T1 + T1p + (hi == 0 ? T0p : 0.f);
    float Av[16];
#pragma unroll
    for (int r = 0; r < 16; ++r) {
        const float p = __builtin_amdgcn_exp2f(Sx[r] + (suf[r] + (r < 8 ? offA : offB)));
        if (MASK) { const int kk = 16 * (r >> 3) + 8 * hi + (r & 7); Av[r] = (kk < qlim) ? p : 0.f; } else Av[r] = p;
    }
    carry += (T0 + T1) + (T0p + T1p);
#pragma unroll
    for (int s = 0; s < 2; ++s) { u32x4 w; w.x = cvtpk(Av[8 * s], Av[8 * s + 1]); w.y = cvtpk(Av[8 * s + 2], Av[8 * s + 3]); w.z = cvtpk(Av[8 * s + 4], Av[8 * s + 5]); w.w = cvtpk(Av[8 * s + 6], Av[8 * s + 7]);
        pf[s] = __builtin_bit_cast(bf16x8, w); }
}
__device__ __forceinline__ void attn_phase(const bf16_t* Q, const bf16_t* Kb, const bf16_t* VT, bf16_t* O, LAS unsigned char* lds, int bx, int G, int tid) {
    const int lane = tid & 63, w = __builtin_amdgcn_readfirstlane(tid >> 6);
    const int ql = lane & 31, hi = lane >> 5;
    const int kperm = (ql & 0x13) | ((ql & 4) << 1) | ((ql & 8) >> 1);
    constexpr float THR = -110.0f * LOG2E;
    constexpr int NITEMS = NB * NH * (SEQ / 256);
    const int per = (NITEMS + G - 1) / G;
    const int it_end = (bx + 1) * per < NITEMS ? (bx + 1) * per : NITEMS;
    for (int it = bx * per; it < it_end; ++it) {
        const int bh = it >> 5, qblk = it & 31, b = bh >> 4, h = bh & 15;
        const int win0 = qblk * 256 - 256;
        __syncthreads();
        {
#pragma unroll
            for (int i = 0; i < 8; ++i) {
                const int slot = w * 64 + i * 8 + (lane >> 3), c = (lane & 7) ^ ((slot >> 1) & 7);
                int kpos = win0 + slot; kpos = kpos < 0 ? 0 : kpos;
                __builtin_amdgcn_global_load_lds((const unsigned*)(Kb + ((size_t)b * SEQ + kpos) * DM + h * 64 + c * 8), (LAS unsigned*)(lds + (w * 64 + i * 8) * 128), 16, 0, 0);
            }
#pragma unroll
            for (int i = 0; i < 8; ++i) {
                const int d = w * 8 + i, kc = lane ^ (d & 15);
                int kpos = win0 + 8 * kc; kpos = kpos < 0 ? 0 : kpos;
                __builtin_amdgcn_global_load_lds((const unsigned*)(VT + (size_t)(h * 64 + d) * M + (size_t)b * SEQ + kpos), (LAS unsigned*)(lds + 65536 + d * 1024), 16, 0, 0);
            }
        }
        const int qb = qblk * 8 + w;
        const size_t tok0 = (size_t)b * SEQ + (size_t)qb * 32;
        const bf16_t* qptr = Q + (tok0 + ql) * DM + h * 64 + 8 * hi;
        bf16x8 qf[4];
#pragma unroll
        for (int ks = 0; ks < 4; ++ks) qf[ks] = *(const bf16x8*)(qptr + 16 * ks);
        asm volatile("s_waitcnt vmcnt(0)" ::: "memory");
        __syncthreads();
        f32x16 o0, o1;
#pragma unroll
        for (int r = 0; r < 16; ++r) { o0[r] = 0.f; o1[r] = 0.f; }
        float carry = 0.f;
        const bf16_t* kbase = Kb + ((size_t)b * SEQ + kperm) * DM + h * 64 + 8 * hi;
        const bf16_t* vbase = VT + (size_t)(h * 64 + ql) * M + (size_t)b * SEQ + 8 * hi;
        for (int kt = qb; kt >= 0; --kt) {
            bf16x8 kf[4], vf[2][2];
            const int kr = kt * 32 - win0;
            if (kr >= 0) {
                const int ksl = kr + kperm, sw = (ksl >> 1) & 7;
                const LAS unsigned char* kl = lds + ksl * 128;
#pragma unroll
                for (int ks = 0; ks < 4; ++ks) kf[ks] = *(const LAS bf16x8*)(kl + (((2 * ks + hi) ^ sw) << 4));
                const int kc0 = (kr >> 3) + hi;
#pragma unroll
                for (int dh = 0; dh < 2; ++dh)
#pragma unroll
                    for (int s = 0; s < 2; ++s) vf[dh][s] = *(const LAS bf16x8*)(lds + 65536 + (dh * 32 + ql) * 1024 + (((kc0 + 2 * s) ^ (ql & 15)) << 4));
            } else {
                const bf16_t* kp = kbase + (size_t)kt * 32 * DM; const bf16_t* vp = vbase + kt * 32;
#pragma unroll
                for (int ks = 0; ks < 4; ++ks) kf[ks] = *(const bf16x8*)(kp + 16 * ks);
#pragma unroll
                for (int dh = 0; dh < 2; ++dh)
#pragma unroll
                    for (int s = 0; s < 2; ++s) vf[dh][s] = *(const bf16x8*)(vp + (size_t)dh * 32 * M + 16 * s);
            }
            f32x16 Sx;
#pragma unroll
            for (int r = 0; r < 16; ++r) Sx[r] = 0.f;
#pragma unroll
            for (int ks = 0; ks < 4; ++ks) Sx = __builtin_amdgcn_mfma_f32_32x32x16_bf16(kf[ks], qf[ks], Sx, 0, 0, 0);
            bf16x8 pf[2];
            if (kt == qb) sb_tile<true>(Sx, carry, hi, ql, pf); else sb_tile<false>(Sx, carry, hi, 0, pf);
#pragma unroll
            for (int s = 0; s < 2; ++s) { o0 = __builtin_amdgcn_mfma_f32_32x32x16_bf16(vf[0][s], pf[s], o0, 0, 0, 0); o1 = __builtin_amdgcn_mfma_f32_32x32x16_bf16(vf[1][s], pf[s], o1, 0, 0, 0); }
            if (__ballot(carry > THR) == 0ull) break;
        }
        bf16_t* op = O + (tok0 + ql) * DM + h * 64 + 4 * hi;
#pragma unroll
        for (int r4 = 0; r4 < 4; ++r4) {
            u32x2 w0; w0.x = cvtpk(o0[4 * r4], o0[4 * r4 + 1]); w0.y = cvtpk(o0[4 * r4 + 2], o0[4 * r4 + 3]);
            u32x2 w1; w1.x = cvtpk(o1[4 * r4], o1[4 * r4 + 1]); w1.y = cvtpk(o1[4 * r4 + 2], o1[4 * r4 + 3]);
            *(u32x2*)(op + 8 * r4) = w0; *(u32x2*)(op + 32 + 8 * r4) = w1;
        }
    }
    __syncthreads();
}

#define XB_TMO      128
#define XB_XCNT(j)  (256  + 64 * (j))
#define XB_XSUB(j)  (1280 + 64 * (j))
#define XB_XGEN(j)  (2304 + 64 * (j))
#define XB_TOP      3328
#define XB_TOPGEN   3392
#define XCD_BAR_WORDS 3456
#define XB_SPIN_CAP (1u << 18)

__device__ __forceinline__ unsigned xb_ld(unsigned* p)              { return __hip_atomic_load(p, __ATOMIC_RELAXED, __HIP_MEMORY_SCOPE_AGENT); }
__device__ __forceinline__ unsigned xb_add(unsigned* p, unsigned v) { return __hip_atomic_fetch_add(p, v, __ATOMIC_RELAXED, __HIP_MEMORY_SCOPE_AGENT); }
__device__ __forceinline__ unsigned xb_xcc_id() { return (unsigned)__builtin_amdgcn_s_getreg((3 << 11) | 20) & 0xFu; }
#define XB_SPIN(cond, bar) do { unsigned _sp = 0; while (cond) { __builtin_amdgcn_s_sleep(1); \
    if ((++_sp & 255u) == 0u) { if (xb_ld(&(bar)[XB_TMO])) break; if (_sp > XB_SPIN_CAP) { atomicAdd(&(bar)[XB_TMO], 1u); break; } } } } while (0)

struct XcdBarrier {
    unsigned* bar; unsigned x;
    volatile LAS unsigned* st;
};

__device__ __forceinline__ XcdBarrier xcd_barrier_post(unsigned* bar, volatile LAS unsigned* st) {
    XcdBarrier b; b.bar = bar; b.x = xb_xcc_id(); b.st = st;
    if (threadIdx.x == 0) (void)xb_add(&bar[XB_XCNT(b.x)], 1u);
    return b;
}
__device__ __forceinline__ void xcd_barrier_complete(unsigned* bar, unsigned x, unsigned& nloc, unsigned& nx) {
    const unsigned G = gridDim.x * gridDim.y * gridDim.z;
    unsigned sum, cnt, mine, sp = 0u;
    for (;;) {
        sum = 0u; cnt = 0u; mine = 0u;
#pragma unroll
        for (unsigned j = 0; j < 16; ++j) { const unsigned c = xb_ld(&bar[XB_XCNT(j)]); sum += c; cnt += (c > 0u) ? 1u : 0u; mine = (j == x) ? c : mine; }
        if (sum == G) break;
        __builtin_amdgcn_s_sleep(1);
        if ((++sp & 255u) == 0u) { if (xb_ld(&bar[XB_TMO])) break; if (sp > XB_SPIN_CAP) { atomicAdd(&bar[XB_TMO], 1u); break; } }
    }
    nloc = mine > 0u ? mine : 1u; nx = cnt > 0u ? cnt : 1u;
}

__device__ __forceinline__ void xcd_barrier(const XcdBarrier& b) {
    asm volatile("s_waitcnt vmcnt(0)" ::: "memory");
    __syncthreads();
    if (threadIdx.x == 0) {
        unsigned* bar = b.bar;
        __builtin_amdgcn_s_waitcnt(0);
        unsigned nloc = b.st[0], nx = b.st[1];
        if (nloc == 0u) { xcd_barrier_complete(bar, b.x, nloc, nx); b.st[0] = nloc; b.st[1] = nx; }
        const unsigned old = xb_add(&bar[XB_XSUB(b.x)], 1u);
        const unsigned gen = old / nloc;
        if (old + 1u == (gen + 1u) * nloc) {
            __builtin_amdgcn_fence(__ATOMIC_RELEASE, "agent");
            asm volatile("s_waitcnt vmcnt(0)" ::: "memory");
            const unsigned og = xb_add(&bar[XB_TOP], 1u);
            const unsigned tg = og / nx;
            if (og + 1u == (tg + 1u) * nx) xb_add(&bar[XB_TOPGEN], 1u);
            else XB_SPIN(xb_ld(&bar[XB_TOPGEN]) == tg, bar);
            __builtin_amdgcn_fence(__ATOMIC_ACQUIRE, "agent");
            xb_add(&bar[XB_XGEN(b.x)], 1u);
            asm volatile("s_waitcnt vmcnt(0)" ::: "memory");
        } else {
            XB_SPIN(xb_ld(&bar[XB_XGEN(b.x)]) == gen, bar);
            __builtin_amdgcn_fence(__ATOMIC_ACQUIRE, "agent");
            asm volatile("s_waitcnt vmcnt(0)" ::: "memory");
        }
    }
    __syncthreads();
}

constexpr int NSTEPS = 16;
__global__ void __launch_bounds__(512, 2) yoco_fwd(Args a_unused) {
    extern __shared__ __attribute__((aligned(16))) unsigned char lds_raw[];
    LAS unsigned char* lds = (LAS unsigned char*)lds_raw;
    const int st_lo = get_args()->st_lo, st_hi = get_args()->st_hi;
    volatile LAS unsigned* MISC = (volatile LAS unsigned*)(lds + RING_BYTES + 4096);
    if (threadIdx.x < 8) MISC[threadIdx.x] = 0u;
    __syncthreads();
    if (st_hi - st_lo > 1 && blockIdx.x == 0) {
        unsigned* bw = (unsigned*)(get_args()->ws + WS_BAR);
        for (int i = threadIdx.x; i < XCD_BAR_WORDS; i += 512) bw[i] = 0u;
    }
    for (int sti = st_lo; sti < st_hi; ++sti) {
        const int st = (sti <= MK_REP) ? sti : sti - 1;
        KArgs ap = get_args();
        unsigned char* ws = ap->ws;
        int tid = threadIdx.x; asm volatile("" : "+v"(tid));
        const int lane = tid & 63, wave = __builtin_amdgcn_readfirstlane(tid >> 6);
        const int G = gridDim.x, bx = blockIdx.x;
        const int gw = bx * 8 + wave, NGW = G * 8;
        if (st == 0) {
            prep_phase(ap, lds, gw, NGW, wave, lane);
        } else if (st == 3) {
            pool_in_phase((const bf16_t*)(ws + WS_HBB), (const float*)(ws + WS_SSB), (bf16_t*)(ws + WS_HBA), gw, NGW, lane);
        } else if (st == 12) {
            attn_phase((const bf16_t*)(ws + WS_HBB), (const bf16_t*)(ws + WS_K), (const bf16_t*)(ws + WS_VT), (bf16_t*)(ws + WS_HID), lds, bx, G, tid);
        } else if (st == 1 || st == 5 || st == 9 || st == 14) {
            const int f = (st == 1) ? 0 : (st == 5) ? 1 : (st == 9) ? 2 : 3;
            const bool useA = (st == 1 || st == 5);
            pg8::Gemm g{(const bf16_t*)(ws + (useA ? WS_HBA : WS_HBB)), (const bf16_t*)(ws + WS_WIN + f * WIN_BYTES), DM, DM, DM, 0};
            pg8::StaticOrder S; S.init(M / 256, NIN / 256, G, bx); S.mode = 1;
            pg8::EpiSwiGLU E{(bf16_t*)(ws + WS_HID), (const float*)(ws + (useA ? WS_SSA : WS_SSB))};
            pg8::gemm_phase(lds, g, S, E, tid);
        } else if (st == 7 || st == 11) {
            const bool isK = (st == 7);
            pg8::Gemm g{(const bf16_t*)(ws + (isK ? WS_HBB : WS_HBA)), (const bf16_t*)(ws + (isK ? WS_WK : WS_WQ)), DM, DM, DM, 0};
            pg8::StaticOrder S; S.init(M / 256, DM / 256, G, bx);
            pg8::EpiHeadNorm E{(bf16_t*)(ws + (isK ? WS_K : WS_HBB)), (const float*)(ws + (isK ? WS_SSB : WS_SSA)), ap->in[isK ? 12 : 15], isK ? 1.0f : 0.125f * LOG2E};
            pg8::gemm_phase(lds, g, S, E, tid);
        } else if (st == 8) {
            pg8::Gemm g{(const bf16_t*)(ws + WS_WV), (const bf16_t*)(ws + WS_HBB), DM, DM, DM, 0};
            pg8::StaticOrder S; S.init(DM / 256, M / 256, G, bx);
            pg8::EpiVT E{(bf16_t*)(ws + WS_VT), (const float*)(ws + WS_SSB)};
            pg8::gemm_phase(lds, g, S, E, tid);
        } else {
            const bool isP = (st == 4), isO = (st == 13), isF = !(isP || isO);
            const int f = (st == 2) ? 0 : (st == 6) ? 1 : (st == 10) ? 2 : 3;
            const bf16_t* gA = (const bf16_t*)(ws + ((isF || isO) ? WS_HID : WS_HBA));
            const bf16_t* gB = (const bf16_t*)(ws + (isP ? WS_WP : isO ? WS_WO : WS_WOUT + f * WOUT_BYTES));
            const int lda = isF ? FF : DM, ldb = isP ? 256 : isO ? DM : FF;
            pg8::Gemm g{gA, gB, lda, ldb, ldb, isP ? 512 : 0};
            const bool toA = (st == 4 || st == 10);
            pg8::EpiRes E{(const bf16_t*)(ws + ((toA || st == 15) ? WS_HBB : WS_HBA)), (bf16_t*)(ws + (toA ? WS_HBA : WS_HBB)), ap->out, (float*)(ws + (toA ? WS_SSA : WS_SSB)), (st == 15) ? 1 : 0};
            pg8::StaticOrder S; S.init(M / 256, DM / 256, G, bx);
            pg8::gemm_phase(lds, g, S, E, tid);
        }
        if (sti + 1 < st_hi && st != 7 && st != 8) {
            if (sti == st_lo) { cg::this_grid().sync(); (void)xcd_barrier_post((unsigned*)(ws + WS_BAR), MISC); }
            else { XcdBarrier xb; xb.bar = (unsigned*)(ws + WS_BAR); xb.x = xb_xcc_id(); xb.st = MISC; xcd_barrier(xb); }
        }
    }
}

extern "C" void kernel_launch(void* const* d_in, const int* in_sizes, int n_in, void* d_out, int out_size, void* d_ws, size_t ws_size, hipStream_t stream) {
    static int grid = 0;
    if (grid == 0) {
        if (n_in != 17 || out_size != M * DM || ws_size < WS_END) { fprintf(stderr, "kernel_launch: unexpected shapes (n_in %d out %d ws %zu)\n", n_in, out_size, ws_size); grid = -1; return; }
        int dev = 0, cus = 0, per_cu = 0;
        hipGetDevice(&dev);
        hipDeviceGetAttribute(&cus, hipDeviceAttributeMultiprocessorCount, dev);
        hipFuncSetAttribute((const void*)yoco_fwd, hipFuncAttributeMaxDynamicSharedMemorySize, LDS_BYTES);
        hipOccupancyMaxActiveBlocksPerMultiprocessor(&per_cu, (const void*)yoco_fwd, 512, LDS_BYTES);
        (void)hipGetLastError();
        if (per_cu < 1) per_cu = 1;
        grid = cus * per_cu;
    }
    if (grid < 0) return;
    Args a{};
    for (int i = 0; i < 17; ++i) a.in[i] = (const float*)d_in[i];
    a.out = (float*)d_out; a.ws = (unsigned char*)d_ws;
#if MK_SINGLE
    a.st_lo = 0; a.st_hi = NSTEPS + (MK_REP < NSTEPS ? 1 : 0);
    void* args[] = {&a};
    hipError_t e = hipLaunchCooperativeKernel((const void*)yoco_fwd, dim3(grid), dim3(512), args, LDS_BYTES, stream);
    if (e != hipSuccess) fprintf(stderr, "cooperative launch failed: %s (grid %d)\n", hipGetErrorString(e), grid);
#else
    for (int st = 0; st < NSTEPS; ++st) {
        a.st_lo = st; a.st_hi = st + 1;
        hipLaunchKernelGGL(yoco_fwd, dim3(grid), dim3(512), LDS_BYTES, stream, a);
    }
#endif
}
```

```cpp
#include <hip/hip_runtime.h>
#include <hip/hip_cooperative_groups.h>
#include <cstdio>
#include <cstdint>
namespace cg = cooperative_groups;

#ifndef MK_SINGLE
#define MK_SINGLE 1
#endif

#ifndef MK_REP
#define MK_REP 99
#endif
#define LAS __attribute__((address_space(3)))
typedef unsigned short bf16_t;
typedef short bf16x8 __attribute__((ext_vector_type(8)));
typedef float f32x4 __attribute__((ext_vector_type(4)));
typedef float f32x16 __attribute__((ext_vector_type(16)));
typedef unsigned u32x4 __attribute__((ext_vector_type(4)));
typedef unsigned u32x2 __attribute__((ext_vector_type(2)));
typedef float f32x2_t __attribute__((ext_vector_type(2)));
typedef __bf16 bf16x2_t __attribute__((ext_vector_type(2)));

constexpr int DM = 1024, NB = 8, SEQ = 8192, M = NB * SEQ, NH = 16, HD = 64, FF = 2816, NIN = 2 * FF;
constexpr float EPS = 1e-6f;
constexpr float LOG2E = 1.4426950408889634f, LN2 = 0.6931471805599453f;

constexpr size_t MiB = 1u << 20;
constexpr size_t WS_SSA = 0, WS_SSB = 1 * MiB;
constexpr size_t WS_BAR = 2 * MiB;
constexpr size_t WS_WIN = 4 * MiB, WIN_BYTES = (size_t)NIN * DM * 2;
constexpr size_t WS_WOUT = 48 * MiB, WOUT_BYTES = (size_t)DM * FF * 2;
constexpr size_t WS_WK = 70 * MiB, WS_WV = 72 * MiB, WS_WQ = 74 * MiB, WS_WO = 76 * MiB, WS_WP = 78 * MiB;
constexpr size_t WS_HBA = 80 * MiB, WS_HBB = 208 * MiB;
constexpr size_t WS_HID = 336 * MiB;
constexpr size_t WS_K = 688 * MiB, WS_VT = 816 * MiB, WS_END = 944 * MiB;
static_assert(WS_WIN + 4 * WIN_BYTES <= WS_WOUT && WS_WOUT + 4 * WOUT_BYTES <= WS_WK, "ws map");
static_assert(WS_HID + (size_t)M * FF * 2 <= WS_K, "ws map");

constexpr int RING_BYTES = 131072, SCR_OFF = RING_BYTES, SS_OFF = RING_BYTES + 8192, LDS_BYTES = RING_BYTES + 16384;

__device__ __forceinline__ unsigned cvtpk(float lo, float hi) { f32x2_t v = {lo, hi}; bf16x2_t b = __builtin_convertvector(v, bf16x2_t); return __builtin_bit_cast(unsigned, b); }
__device__ __forceinline__ float rstd_from(const f32x4 s) { float a = s[0] + s[1], b = s[2] + s[3]; asm volatile("" : "+v"(a), "+v"(b));
    return __builtin_amdgcn_rsqf((a + b) * (1.0f / DM) + EPS); }

__device__ __forceinline__ f32x4 zero4() {
    typedef unsigned long long u64x2 __attribute__((ext_vector_type(2)));
    unsigned long long a, b; asm volatile("v_mov_b64 %0, 0\n\tv_mov_b64 %1, 0" : "=v"(a), "=v"(b));
    u64x2 v = {a, b}; return __builtin_bit_cast(f32x4, v);
}
namespace pg8 {
constexpr int BM = 256, BK = 64, HALF = 128, HTB = HALF * BK * 2, NXCD = 8, WGM = 8;
__device__ __forceinline__ int lds_byte(int r, int c) { const int st = (r >> 4) * 2 + (c >> 5), rr = r & 15, cc = c & 31, ob = rr * 64 + cc * 2; return st * 1024 + (ob ^ (((ob >> 9) & 1) << 5)); }
__device__ __forceinline__ void stage_rc(int b, int& R, int& C) { const int st = b / 1024, sb = b % 1024, swz = sb ^ (((sb >> 9) & 1) << 5); R = (st >> 1) * 16 + swz / 64; C = (st & 1) * 32 + (swz % 64) / 2; }
__device__ __forceinline__ int perm32(int rho) { const int n = rho >> 4, i = rho & 15; return 8 * (i >> 2) + 4 * n + (i & 3); }

struct Unit { int pm, pn; };
struct Gemm { const bf16_t* A; const bf16_t* Bt; int lda, ldb, K, a_pn_bytes; };

struct StaticOrder {
    int nM, nN, nwg, G, c, mode = 0;
    __device__ __forceinline__ void init(int nM_, int nN_, int G_, int c_) { nM = nM_; nN = nN_; nwg = nM * nN; G = G_; c = c_; }
    __device__ __forceinline__ bool next(int i, Unit& u) const {
        const long L = (long)i * G + c; if (L >= nwg) return false;
        int wgid = (int)L;
        if (mode == 1) {
            const int xcd = wgid & 7, p = wgid >> 3; int pml, pn;
            if (p < 640) { const int j = p >> 7, rem = p & 127, b = rem >> 5, k = rem & 31; pml = 8 * b + (k & 7); pn = 4 * j + (k >> 3); }
            else { const int pp = p - 640, b = pp >> 4, k = pp & 15; pml = 8 * b + (k & 7); pn = 20 + (k >> 3); }
            u.pm = 32 * xcd + pml; u.pn = pn; return true;
        } { const int q = nwg / NXCD, r = nwg % NXCD, xcd = wgid % NXCD, off = wgid / NXCD; wgid = (xcd < r ? xcd * (q + 1) : r * (q + 1) + (xcd - r) * q) + off; }
        const int nig = WGM * nN, gid = wgid / nig, fm = gid * WGM, gsz = (nM - fm) < WGM ? (nM - fm) : WGM;
        u.pm = fm + ((wgid % nig) % gsz); u.pn = (wgid % nig) / gsz; return true;
    }
};


struct EpiSwiGLU {
    static constexpr int SS_STAGE = 1;
    bf16_t* H; const float* ss4;
    __device__ __forceinline__ void operator()(const f32x4 (&acc)[2][2][4][2], const Unit& u, int wr, int wc, int fr, int fq, int tid, LAS float* scr, int sbuf) const {
        const int row0 = u.pm * BM + wr * 64 + fr, col0 = u.pn * 128 + wc * 32 + 8 * fq;
        f32x4 sv[2][4];
#pragma unroll
        for (int ai = 0; ai < 2; ++ai)
#pragma unroll
            for (int m = 0; m < 4; ++m) sv[ai][m] = *(const LAS f32x4*)((const LAS unsigned char*)scr + 8192 + sbuf * 4096 + (ai * HALF + wr * 64 + m * 16 + fr) * 16);
#pragma unroll
        for (int ai = 0; ai < 2; ++ai)
#pragma unroll
            for (int m = 0; m < 4; ++m) {
                const int row = row0 + ai * HALF + m * 16;
                const float rs = rstd_from(sv[ai][m]), rs2 = rs * (-LOG2E), irsq = __builtin_amdgcn_rcpf(rs * rs);
                float o[8];
#pragma unroll
                for (int n = 0; n < 2; ++n)
#pragma unroll
                    for (int p = 0; p < 2; ++p) {
                        const f32x2_t ag = {acc[ai][0][m][n][2 * p], acc[ai][0][m][n][2 * p + 1]}, au = {acc[ai][1][m][n][2 * p], acc[ai][1][m][n][2 * p + 1]};
                        const f32x2_t t = ag * rs2;
                        f32x2_t d; d.x = __builtin_amdgcn_exp2f(t.x); d.y = __builtin_amdgcn_exp2f(t.y); d = d * irsq + irsq;
                        f32x2_t r; r.x = __builtin_amdgcn_rcpf(d.x); r.y = __builtin_amdgcn_rcpf(d.y);
                        const f32x2_t res = (ag * au) * r;
                        o[n * 4 + 2 * p] = res.x; o[n * 4 + 2 * p + 1] = res.y;
                    }
                u32x4 w; w.x = cvtpk(o[0], o[1]); w.y = cvtpk(o[2], o[3]); w.z = cvtpk(o[4], o[5]); w.w = cvtpk(o[6], o[7]);
                *(u32x4*)(H + (size_t)row * FF + col0) = w;
            }
    }
};

__device__ __forceinline__ void unpack8v(const u32x4 p, f32x4& a, f32x4& b) {
    a[0] = __builtin_bit_cast(float, p[0] << 16); a[1] = __builtin_bit_cast(float, p[0] & 0xffff0000u); a[2] = __builtin_bit_cast(float, p[1] << 16); a[3] = __builtin_bit_cast(float, p[1] & 0xffff0000u);
    b[0] = __builtin_bit_cast(float, p[2] << 16); b[1] = __builtin_bit_cast(float, p[2] & 0xffff0000u); b[2] = __builtin_bit_cast(float, p[3] << 16); b[3] = __builtin_bit_cast(float, p[3] & 0xffff0000u);
}
template <bool FIN> struct EpiRes {
    static constexpr int SS_STAGE = 0;
    const bf16_t* res; bf16_t* outb; float* outf; float* ss4;
    __device__ __forceinline__ void operator()(const f32x4 (&acc)[2][2][4][2], const Unit& u, int wr, int wc, int fr, int fq, int tid, LAS float* scr, int sbuf) const {
        const int row0 = u.pm * BM + wr * 64 + fr, col0 = u.pn * BM + wc * 32 + 8 * fq;
        u32x4 rv[2][4][2];
#pragma unroll
        for (int ai = 0; ai < 2; ++ai)
#pragma unroll
            for (int m = 0; m < 4; ++m)
#pragma unroll
                for (int bj = 0; bj < 2; ++bj) rv[ai][m][bj] = *(const u32x4*)(res + (size_t)(row0 + ai * HALF + m * 16) * DM + col0 + bj * HALF);
        float s8[8];
#pragma unroll
        for (int ai = 0; ai < 2; ++ai) {
#pragma unroll
            for (int m = 0; m < 4; ++m) {
                const int row = row0 + ai * HALF + m * 16; f32x2_t sq = {0.f, 0.f};
#pragma unroll
                for (int bj = 0; bj < 2; ++bj) {
                    const size_t off = (size_t)row * DM + col0 + bj * HALF;
                    const u32x4 p = rv[ai][m][bj]; f32x2_t v[4];
#pragma unroll
                    for (int q = 0; q < 4; ++q) {
                        const f32x2_t r = {__builtin_bit_cast(float, p[q] << 16), __builtin_bit_cast(float, p[q] & 0xffff0000u)};
                        const f32x2_t a = {acc[ai][bj][m][q >> 1][2 * (q & 1)], acc[ai][bj][m][q >> 1][2 * (q & 1) + 1]};
                        v[q] = r + a; if (!FIN) sq = v[q] * v[q] + sq;
                    }
                    if (FIN) { *(f32x4*)(outf + off) = (f32x4){v[0].x, v[0].y, v[1].x, v[1].y}; *(f32x4*)(outf + off + 4) = (f32x4){v[2].x, v[2].y, v[3].x, v[3].y}; }
                    else { u32x4 w; w.x = cvtpk(v[0].x, v[0].y); w.y = cvtpk(v[1].x, v[1].y); w.z = cvtpk(v[2].x, v[2].y); w.w = cvtpk(v[3].x, v[3].y); *(u32x4*)(outb + off) = w; }
                }
                s8[ai * 4 + m] = sq.x + sq.y;
            }
        }
        if (!FIN) {
            float t8[8];
#pragma unroll
            for (int i = 0; i < 8; ++i) t8[i] = __shfl_xor(s8[i], 16);
#pragma unroll
            for (int i = 0; i < 8; ++i) s8[i] += t8[i];
#pragma unroll
            for (int i = 0; i < 8; ++i) t8[i] = __shfl_xor(s8[i], 32);
#pragma unroll
            for (int i = 0; i < 8; ++i) if (fq == 0) scr[((i >> 2) * HALF + wr * 64 + (i & 3) * 16 + fr) * 4 + wc] = s8[i] + t8[i];
            asm volatile("s_waitcnt lgkmcnt(0)" ::: "memory"); __builtin_amdgcn_s_barrier(); asm volatile("" ::: "memory");
            if (tid < 256) { const f32x4 p = *(const LAS f32x4*)(scr + tid * 4); ss4[(size_t)(u.pm * BM + tid) * 4 + u.pn] = (p[0] + p[1]) + (p[2] + p[3]); }
        }
    }
};

struct EpiHeadNorm {
    static constexpr int SS_STAGE = 1;
    bf16_t* O; const float* ss4; const float* gain; float oscale;
    __device__ __forceinline__ void operator()(const f32x4 (&acc)[2][2][4][2], const Unit& u, int wr, int wc, int fr, int fq, int tid, LAS float* scr, int sbuf) const {
        const int row0 = u.pm * BM + wr * 64 + fr, colh = (u.pn * 4 + wc) * 64 + 8 * fq;
        f32x4 gv[2][2];
#pragma unroll
        for (int bj = 0; bj < 2; ++bj)
#pragma unroll
            for (int n = 0; n < 2; ++n) gv[bj][n] = *(const f32x4*)(gain + 32 * bj + 8 * fq + 4 * n);
        f32x4 sv[2][4];
#pragma unroll
        for (int ai = 0; ai < 2; ++ai)
#pragma unroll
            for (int m = 0; m < 4; ++m) sv[ai][m] = *(const LAS f32x4*)((const LAS unsigned char*)scr + 8192 + sbuf * 4096 + (ai * HALF + wr * 64 + m * 16 + fr) * 16);
#pragma unroll
        for (int ai = 0; ai < 2; ++ai)
#pragma unroll
            for (int m = 0; m < 4; ++m) {
                const int row = row0 + ai * HALF + m * 16;
                const float rs = rstd_from(sv[ai][m]);
                f32x4 v[2][2]; float s = 0.f;
#pragma unroll
                for (int bj = 0; bj < 2; ++bj)
#pragma unroll
                    for (int n = 0; n < 2; ++n) { v[bj][n] = acc[ai][bj][m][n] * rs; const f32x4 x = v[bj][n]; s += (x[0] * x[0] + x[1] * x[1]) + (x[2] * x[2] + x[3] * x[3]); }
                s += __shfl_xor(s, 16); s += __shfl_xor(s, 32);
                const float hr = __builtin_amdgcn_rsqf(s * (1.0f / HD) + EPS) * oscale;
#pragma unroll
                for (int bj = 0; bj < 2; ++bj) {
                    const f32x4 a = v[bj][0] * gv[bj][0] * hr, b = v[bj][1] * gv[bj][1] * hr;
                    u32x4 w; w.x = cvtpk(a[0], a[1]); w.y = cvtpk(a[2], a[3]); w.z = cvtpk(b[0], b[1]); w.w = cvtpk(b[2], b[3]);
                    *(u32x4*)(O + (size_t)row * DM + colh + 32 * bj) = w;
                }
            }
    }
};

struct EpiVT {
    static constexpr int SS_STAGE = 2;
    bf16_t* VT; const float* ss4;
    __device__ __forceinline__ void operator()(const f32x4 (&acc)[2][2][4][2], const Unit& u, int wr, int wc, int fr, int fq, int tid, LAS float* scr, int sbuf) const {
        const int row0 = u.pm * BM + wr * 64 + fr, col0 = u.pn * BM + wc * 32 + 8 * fq;
        float rs[2][8];
#pragma unroll
        for (int bj = 0; bj < 2; ++bj)
#pragma unroll
            for (int j = 0; j < 8; ++j) rs[bj][j] = rstd_from(*(const LAS f32x4*)((const LAS unsigned char*)scr + 8192 + sbuf * 4096 + (bj * HALF + wc * 32 + 8 * fq + j) * 16));
#pragma unroll
        for (int ai = 0; ai < 2; ++ai)
#pragma unroll
            for (int m = 0; m < 4; ++m) {
                const int row = row0 + ai * HALF + m * 16;
#pragma unroll
                for (int bj = 0; bj < 2; ++bj) {
                    const f32x4 a = acc[ai][bj][m][0], b = acc[ai][bj][m][1];
                    u32x4 w; w.x = cvtpk(a[0] * rs[bj][0], a[1] * rs[bj][1]); w.y = cvtpk(a[2] * rs[bj][2], a[3] * rs[bj][3]);
                    w.z = cvtpk(b[0] * rs[bj][4], b[1] * rs[bj][5]); w.w = cvtpk(b[2] * rs[bj][6], b[3] * rs[bj][7]);
                    *(u32x4*)(VT + (size_t)row * M + col0 + bj * HALF) = w;
                }
            }
    }
};

template <class Epi>
__device__ __forceinline__ void gemm_phase(LAS unsigned char* lds, const Gemm g, const StaticOrder& S, const Epi& E, const int tid) {
    const int wid = __builtin_amdgcn_readfirstlane(tid >> 6), lane = tid & 63, wr = wid >> 2, wc = wid & 3, fr = lane & 15, fq = lane >> 4;
    const int K = g.K, nt = K / BK;
    unsigned voffA[2], voffB[2];
#pragma unroll
    for (int i = 0; i < 2; ++i) { int R, C; stage_rc(tid * 16 + i * 8192, R, C); const int Rb = (R & ~31) + perm32(R & 31);
        voffA[i] = (unsigned)(R * g.lda + C) * 2u; voffB[i] = (unsigned)(Rb * g.ldb + C) * 2u; }
    const size_t kstep = (size_t)(BK * 2);
    const size_t hstepA = (size_t)HALF * g.lda * 2, hstepB = (size_t)HALF * g.ldb * 2;
    const size_t tstepA = 2 * hstepA, tstepB = 2 * hstepB;
    const unsigned ldsw = (unsigned)wid * 1024u;
    const int aoff = lds_byte(wr * 64 + fr, fq * 8), boff = lds_byte(wc * 32 + fr, fq * 8);
#define PG8_SA(b, h) (((b) * 2 + (h)) * HTB)
#define PG8_SB(b, h) ((4 + (b) * 2 + (h)) * HTB)
#define PG8_STAGE(bufoff, gbase, voff) do { _Pragma("unroll") for (int _i = 0; _i < 2; ++_i) \
        __builtin_amdgcn_global_load_lds((const unsigned*)((const char*)(gbase) + (voff)[_i]), (LAS unsigned*)(lds + (bufoff) + ldsw + _i * 8192), 16, 0, 0); } while (0)
#define PG8_LDA(dst, b, h) do { _Pragma("unroll") for (int m = 0; m < 4; ++m) _Pragma("unroll") for (int k = 0; k < 2; ++k) dst[m][k] = *(const LAS bf16x8*)(lds + PG8_SA(b, h) + aoff + m * 2048 + k * 1024); } while (0)
#define PG8_LDB(dst, b, h) do { _Pragma("unroll") for (int n = 0; n < 2; ++n) _Pragma("unroll") for (int k = 0; k < 2; ++k) dst[n][k] = *(const LAS bf16x8*)(lds + PG8_SB(b, h) + boff + n * 2048 + k * 1024); } while (0)
#define PG8_MMA(ai, bj, At, Bt) do { __builtin_amdgcn_s_setprio(1); _Pragma("unroll") for (int m = 0; m < 4; ++m) _Pragma("unroll") for (int n = 0; n < 2; ++n) _Pragma("unroll") for (int k = 0; k < 2; ++k) \
        acc[ai][bj][m][n] = __builtin_amdgcn_mfma_f32_16x16x32_bf16(Bt[n][k], At[m][k], acc[ai][bj][m][n], 0, 0, 0); __builtin_amdgcn_s_setprio(0); } while (0)
#define PG8_WAIT_V(n) asm volatile("s_waitcnt vmcnt(" #n ")" ::: "memory")
#define PG8_WAIT_L(n) asm volatile("s_waitcnt lgkmcnt(" #n ")" ::: "memory")
#define PG8_BAR __builtin_amdgcn_s_barrier()
#define PG8_SCHED __builtin_amdgcn_sched_barrier(0)
    Unit cur, nxt; int ui = 0;
    if (!S.next(0, cur)) return;
#define PG8_SS_PREFETCH(U, BUF) do { if (Epi::SS_STAGE != 0 && wid < 4) { const char* sb_ = (const char*)E.ss4 + (size_t)((Epi::SS_STAGE == 2 ? (U).pn : (U).pm) * BM + wid * 64) * 16; \
        __builtin_amdgcn_global_load_lds((const unsigned*)(sb_ + (unsigned)lane * 16u), (LAS unsigned*)(lds + SS_OFF + (BUF) * 4096 + wid * 1024), 16, 0, 0); } } while (0)
    PG8_SS_PREFETCH(cur, 0);
    f32x4 acc[2][2][4][2];
#pragma unroll
    for (int a = 0; a < 2; ++a)
#pragma unroll
        for (int b = 0; b < 2; ++b)
#pragma unroll
            for (int m = 0; m < 4; ++m)
#pragma unroll
                for (int n = 0; n < 2; ++n) acc[a][b][m][n] = zero4();
    bf16x8 At[4][2], B0[2][2], B1[2][2];
    const char* cA = (const char*)g.A + (size_t)cur.pm * tstepA + (size_t)cur.pn * g.a_pn_bytes; const char* cB = (const char*)g.Bt + (size_t)cur.pn * tstepB;
    PG8_STAGE(PG8_SB(0, 0), cB, voffB); PG8_STAGE(PG8_SB(0, 1), cB + hstepB, voffB); PG8_STAGE(PG8_SA(0, 0), cA, voffA); PG8_STAGE(PG8_SA(0, 1), cA + hstepA, voffA);
    if (wr == 1) PG8_BAR;
    PG8_WAIT_V(2); PG8_BAR;
    PG8_STAGE(PG8_SB(1, 0), cB + kstep, voffB); PG8_STAGE(PG8_SA(1, 0), cA + kstep, voffA); PG8_STAGE(PG8_SB(1, 1), cB + hstepB + kstep, voffB);
    PG8_WAIT_V(6); PG8_BAR;
    for (;;) {
        const bool has_next = S.next(ui + 1, nxt);
        const char* nA = has_next ? (const char*)g.A + (size_t)nxt.pm * tstepA + (size_t)nxt.pn * g.a_pn_bytes : cA; const char* nB = has_next ? (const char*)g.Bt + (size_t)nxt.pn * tstepB : cB;
        for (int t = 0; t < nt; t += 2) {
            const bool last = (t == nt - 2);
            const char* a1 = cA + (size_t)(t + 1) * kstep;
            const char* a2 = last ? nA : cA + (size_t)(t + 2) * kstep; const char* b2 = last ? nB : cB + (size_t)(t + 2) * kstep;
            const char* a3 = a2 + kstep; const char* b3 = b2 + kstep;
            PG8_LDB(B0, 0, 0); PG8_LDB(B1, 0, 1); PG8_SCHED; PG8_LDA(At, 0, 0); PG8_STAGE(PG8_SA(1, 1), a1 + hstepA, voffA);
            PG8_WAIT_V(8); PG8_WAIT_L(0); PG8_BAR; PG8_MMA(0, 0, At, B0); PG8_MMA(0, 1, At, B1); PG8_BAR; PG8_SCHED;
            PG8_LDA(At, 0, 1); PG8_STAGE(PG8_SB(0, 0), b2, voffB); PG8_STAGE(PG8_SB(0, 1), b2 + hstepB, voffB); PG8_STAGE(PG8_SA(0, 0), a2, voffA);
            PG8_WAIT_V(8); PG8_WAIT_L(0); PG8_BAR; PG8_MMA(1, 0, At, B0); PG8_MMA(1, 1, At, B1); PG8_BAR; PG8_SCHED;
            PG8_LDB(B0, 1, 0); PG8_LDB(B1, 1, 1); PG8_SCHED; PG8_LDA(At, 1, 0); PG8_STAGE(PG8_SA(0, 1), a2 + hstepA, voffA);
            PG8_WAIT_V(8); PG8_WAIT_L(0); PG8_BAR; PG8_MMA(0, 0, At, B0); PG8_MMA(0, 1, At, B1); PG8_BAR; PG8_SCHED;
            PG8_LDA(At, 1, 1); PG8_STAGE(PG8_SB(1, 0), b3, voffB); PG8_STAGE(PG8_SB(1, 1), b3 + hstepB, voffB); PG8_STAGE(PG8_SA(1, 0), a3, voffA);
            PG8_WAIT_V(8); PG8_WAIT_L(0); PG8_BAR; PG8_MMA(1, 0, At, B0); PG8_MMA(1, 1, At, B1); PG8_BAR; PG8_SCHED;
        }
        if (wr == 0) PG8_BAR;
        E(acc, cur, wr, wc, fr, fq, tid, (LAS float*)(lds + 131072), ui & 1);
        if (!has_next) break;
        PG8_SS_PREFETCH(nxt, (ui + 1) & 1);
#pragma unroll
        for (int a = 0; a < 2; ++a)
#pragma unroll
            for (int b = 0; b < 2; ++b)
#pragma unroll
                for (int m = 0; m < 4; ++m)
#pragma unroll
                    for (int n = 0; n < 2; ++n) acc[a][b][m][n] = zero4();
        cur = nxt; cA = nA; cB = nB; ++ui;
        if (wr == 1) PG8_BAR;
    }
    PG8_WAIT_V(0);
    PG8_BAR;
#undef PG8_SA
#undef PG8_SB
#undef PG8_STAGE
#undef PG8_LDA
#undef PG8_LDB
#undef PG8_MMA
#undef PG8_WAIT_V
#undef PG8_WAIT_L
#undef PG8_BAR
#undef PG8_SCHED
#undef PG8_SS_PREFETCH
}
}

__device__ __forceinline__ void tr_item(const float* W, int ldn, int k0, int n0, const float* gk, const float* cs, bf16_t* WT, int ldk, int drow0, LAS float* scr, int lane, float mul = 1.f) {
    const int n = lane & 31, kh = lane >> 5;
    const float csn = (cs ? cs[n0 + n] : 1.f) * mul;
    float wv[32];
#pragma unroll
    for (int i = 0; i < 32; ++i) wv[i] = W[(size_t)(k0 + 2 * i + kh) * ldn + n0 + n];
#pragma unroll
    for (int i = 0; i < 32; ++i) { const int kk = 2 * i + kh; const float gg = gk ? gk[k0 + kk] : 1.f; scr[kk * 33 + n] = wv[i] * gg * csn; }
    asm volatile("s_waitcnt lgkmcnt(0)" ::: "memory");
    const int c = lane & 7;
#pragma unroll
    for (int j = 0; j < 4; ++j) { const int nn = (lane >> 3) + 8 * j; const LAS float* s = scr + (8 * c) * 33 + nn;
        u32x4 o; o.x = cvtpk(s[0 * 33], s[1 * 33]); o.y = cvtpk(s[2 * 33], s[3 * 33]); o.z = cvtpk(s[4 * 33], s[5 * 33]); o.w = cvtpk(s[6 * 33], s[7 * 33]);
        *(u32x4*)(WT + (size_t)(drow0 + nn) * ldk + k0 + 8 * c) = o; }
    asm volatile("s_waitcnt lgkmcnt(0)" ::: "memory");
}

struct Args { const float* in[17]; float* out; unsigned char* ws; int st_lo, st_hi; };

typedef const __attribute__((address_space(4))) Args* KArgs;
__device__ __forceinline__ KArgs get_args() { const __attribute__((address_space(4))) void* p = (const __attribute__((address_space(4))) void*)__builtin_amdgcn_kernarg_segment_ptr(); asm volatile("" : "+s"(p)); return (KArgs)p; }
__device__ __forceinline__ void prep_phase(KArgs ap, LAS unsigned char* lds, int gw, int NGW, int wave, int lane) {
    LAS float* scr = (LAS float*)(lds + wave * 16384);
    unsigned char* ws = ap->ws;
    constexpr int I_IN = (DM / 64) * (NIN / 32);
    constexpr int I_OUT = (FF / 64) * (DM / 32);
    constexpr int I_SQ = (DM / 64) * (DM / 32);
    constexpr int I_P = 4 * (256 / 64) * (256 / 32);
    constexpr int NITEMS = 4 * I_IN + 4 * I_OUT + 4 * I_SQ + I_P;
    for (int it = gw; it < NITEMS; it += NGW) {
        int r = it;
        if (r < 4 * I_IN) {
            const int f = r / I_IN; r -= f * I_IN; const int l = f >> 1;
            const float* W = ap->in[(f & 1) ? 5 : 2] + (size_t)l * DM * NIN; const float* gk = ap->in[(f & 1) ? 4 : 1] + l * DM;
            const int nblk = NIN / 32, kb = r / nblk, db = r % nblk, R = 32 * db, pn = R >> 8, bj = (R >> 7) & 1, j = R & 127;
            tr_item(W, NIN, 64 * kb, bj * FF + 128 * pn + j, gk, nullptr, (bf16_t*)(ws + WS_WIN + f * WIN_BYTES), DM, R, scr, lane);
            continue;
        }
        r -= 4 * I_IN;
        if (r < 4 * I_OUT) {
            const int f = r / I_OUT; r -= f * I_OUT; const int l = f >> 1;
            const float* W = ap->in[(f & 1) ? 6 : 3] + (size_t)l * FF * DM;
            const int nblk = DM / 32, kb = r / nblk, db = r % nblk;
            tr_item(W, DM, 64 * kb, 32 * db, nullptr, nullptr, (bf16_t*)(ws + WS_WOUT + f * WOUT_BYTES), FF, 32 * db, scr, lane, 0.5f);
            continue;
        }
        r -= 4 * I_OUT;
        if (r < 4 * I_SQ) {
            const int q = r / I_SQ; r -= q * I_SQ; const int kb = r / 32, db = r % 32, R = 32 * db;
            const int srcp = (R & ~255) + 64 * ((R >> 5) & 3) + 32 * ((R >> 7) & 1);
            if (q == 0)      tr_item(ap->in[11], 2 * DM, 64 * kb, srcp, ap->in[10], nullptr, (bf16_t*)(ws + WS_WK), DM, R, scr, lane);
            else if (q == 1) tr_item(ap->in[11], 2 * DM, 64 * kb, DM + R, ap->in[10], nullptr, (bf16_t*)(ws + WS_WV), DM, R, scr, lane);
            else if (q == 2) tr_item(ap->in[14], DM, 64 * kb, srcp, ap->in[13], nullptr, (bf16_t*)(ws + WS_WQ), DM, R, scr, lane);
            else             tr_item(ap->in[16], DM, 64 * kb, R, nullptr, nullptr, (bf16_t*)(ws + WS_WO), DM, R, scr, lane);
            continue;
        }
        r -= 4 * I_SQ;
        { const int gI = r / 32; r -= gI * 32; const int kb = r / 8, db = r % 8;
          tr_item(ap->in[8] + (size_t)gI * 65536, 256, 64 * kb, 32 * db, ap->in[7] + gI * 256, ap->in[9] + gI * 256, (bf16_t*)(ws + WS_WP) + (size_t)gI * 65536, 256, 32 * db, scr, lane); }
    }
    const float* x = ap->in[0]; bf16_t* xb = (bf16_t*)(ws + WS_HBA); float* ss = (float*)(ws + WS_SSA);
    for (int m0 = gw * 4; m0 < M; m0 += NGW * 4) {
        f32x4 v[4][4]; float sq[4];
#pragma unroll
        for (int rr = 0; rr < 4; ++rr) { const f32x4* xr = (const f32x4*)(x + (size_t)(m0 + rr) * DM) + lane;
#pragma unroll
            for (int j = 0; j < 4; ++j) v[rr][j] = xr[64 * j]; }
#pragma unroll
        for (int rr = 0; rr < 4; ++rr) { float s = 0.f;
#pragma unroll
            for (int j = 0; j < 4; ++j) s += (v[rr][j][0] * v[rr][j][0] + v[rr][j][1] * v[rr][j][1]) + (v[rr][j][2] * v[rr][j][2] + v[rr][j][3] * v[rr][j][3]);
            sq[rr] = s; }
#pragma unroll
        for (int o = 1; o < 64; o <<= 1) {
#pragma unroll
            for (int rr = 0; rr < 4; ++rr) sq[rr] += __shfl_xor(sq[rr], o); }
#pragma unroll
        for (int rr = 0; rr < 4; ++rr) { u32x2* o8 = (u32x2*)(xb + (size_t)(m0 + rr) * DM) + lane;
#pragma unroll
            for (int j = 0; j < 4; ++j) { u32x2 w; w.x = cvtpk(v[rr][j][0], v[rr][j][1]); w.y = cvtpk(v[rr][j][2], v[rr][j][3]); o8[64 * j] = w; }
            if (lane == 0) *(f32x4*)(ss + (size_t)(m0 + rr) * 4) = (f32x4){sq[rr], 0.f, 0.f, 0.f}; }
    }
}

__device__ __forceinline__ void unpack8(const u32x4 p, float (&f)[8]) {
#pragma unroll
    for (int i = 0; i < 4; ++i) { f[2 * i] = __builtin_bit_cast(float, p[i] << 16); f[2 * i + 1] = __builtin_bit_cast(float, p[i] & 0xffff0000u); }
}
__device__ __forceinline__ void pool_in_phase(const bf16_t* __restrict__ hb, const float* __restrict__ ss4, bf16_t* __restrict__ P, int gw, int NGW, int lane) {
    const int NITEMS = (M / 32) * 2;
    for (int it = gw; it < NITEMS; it += NGW) {
        const int chunk = it >> 1, strip = it & 1, t0 = chunk * 32, pos0 = t0 & (SEQ - 1);
        float rs = 0.f;
        if (lane < 48 && pos0 + lane - 16 >= 0) rs = rstd_from(*(const f32x4*)(ss4 + (size_t)(t0 - 16 + lane) * 4));
        const int c0 = strip * 512 + lane * 8, w = 2 << (c0 >> 8);
        float S[8];
#pragma unroll
        for (int e = 0; e < 8; ++e) S[e] = 0.f;
#pragma unroll
        for (int j = 1; j <= 16; ++j) {
            const float rj = __shfl(rs, 16 - j);
            if (j <= w && pos0 - j >= 0) { float f[8]; unpack8(*(const u32x4*)(hb + (size_t)(t0 - j) * DM + c0), f);
#pragma unroll
                for (int e = 0; e < 8; ++e) S[e] += f[e] * rj; }
        }
        for (int ib = 0; ib < 4; ++ib) {
            u32x4 xn[8], xo[8];
#pragma unroll
            for (int k = 0; k < 8; ++k) { const int i = ib * 8 + k, t = t0 + i; const bool has = (pos0 + i >= w);
                xn[k] = *(const u32x4*)(hb + (size_t)t * DM + c0); xo[k] = *(const u32x4*)(hb + (size_t)(has ? t - w : t) * DM + c0); }
#pragma unroll
            for (int k = 0; k < 8; ++k) {
                const int i = ib * 8 + k, t = t0 + i, pos = pos0 + i;
                const float rt = __shfl(rs, 16 + i); float ro = __shfl(rs, 16 + i - w); ro = (pos >= w) ? ro : 0.f;
                float xs[8], f[8]; unpack8(xn[k], xs); unpack8(xo[k], f);
#pragma unroll
                for (int e = 0; e < 8; ++e) { xs[e] *= rt; S[e] += xs[e]; S[e] -= f[e] * ro; }
                const int cnt = (pos + 1 < w) ? pos + 1 : w; const float ic = 1.0f / (float)cnt;
                u32x4 o; o.x = cvtpk(S[0] * ic - xs[0], S[1] * ic - xs[1]); o.y = cvtpk(S[2] * ic - xs[2], S[3] * ic - xs[3]);
                o.z = cvtpk(S[4] * ic - xs[4], S[5] * ic - xs[5]); o.w = cvtpk(S[6] * ic - xs[6], S[7] * ic - xs[7]);
                *(u32x4*)(P + (size_t)t * DM + c0) = o;
            }
        }
    }
}

__device__ __forceinline__ float xchg32(float v, int hi) {
    const unsigned u = __builtin_bit_cast(unsigned, v);
    const auto r = __builtin_amdgcn_permlane32_swap(u, u, false, false);
    return __builtin_bit_cast(float, hi ? r[0] : r[1]);
}
template <bool MASK>
__device__ __forceinline__ void sb_tile(const f32x16& Sx, float& carry, int hi, int qlim, bf16x8 (&pf)[2]) {
    float L[16];
#pragma unroll
    for (int r = 0; r < 16; ++r) {
        const float z = Sx[r];
        const float e = __builtin_amdgcn_exp2f(-__builtin_fabsf(z));
        const float sp = __builtin_fmaf(0.5f, z, __builtin_fmaf(0.5f, __builtin_fabsf(z), __builtin_amdgcn_logf(1.0f + e)));
        if (MASK) { const int kk = 16 * (r >> 3) + 8 * hi + (r & 7); L[r] = (kk < qlim) ? -sp : 0.f; } else L[r] = -sp;
    }
    float suf[16];
    suf[7] = L[7]; suf[15] = L[15];
#pragma unroll
    for (int r = 6; r >= 0; --r) { suf[r] = L[r] + suf[r + 1]; suf[8 + r] = L[8 + r] + suf[9 + r]; }
    const float T0 = suf[0], T1 = suf[8];
    const float T0p = xchg32(T0, hi), T1p = xchg32(T1, hi);
    const float offB = carry + (hi == 0 ? T1p : 0.f);
    const float offA = carry + T1 + T1p + (hi == 0 ? T0p : 0.f);
    float Av[16];
#pragma unroll
    for (int r = 0; r < 16; ++r) {
        const float p = __builtin_amdgcn_exp2f(Sx[r] + (suf[r] + (r < 8 ? offA : offB)));
        if (MASK) { const int kk = 16 * (r >> 3) + 8 * hi + (r & 7); Av[r] = (kk < qlim) ? p : 0.f; } else Av[r] = p;
    }
    carry += (T0 + T1) + (T0p + T1p);
#pragma unroll
    for (int s = 0; s < 2; ++s) { u32x4 w; w.x = cvtpk(Av[8 * s], Av[8 * s + 1]); w.y = cvtpk(Av[8 * s + 2], Av[8 * s + 3]); w.z = cvtpk(Av[8 * s + 4], Av[8 * s + 5]); w.w = cvtpk(Av[8 * s + 6], Av[8 * s + 7]);
        pf[s] = __builtin_bit_cast(bf16x8, w); }
}
__device__ __forceinline__ void attn_phase(const bf16_t* Q, const bf16_t* Kb, const bf16_t* VT, bf16_t* O, LAS unsigned char* lds, int bx, int G, int tid) {
    const int lane = tid & 63, w = __builtin_amdgcn_readfirstlane(tid >> 6);
    const int ql = lane & 31, hi = lane >> 5;
    const int kperm = (ql & 0x13) | ((ql & 4) << 1) | ((ql & 8) >> 1);
    constexpr float THR = -110.0f * LOG2E;
    constexpr int NITEMS = NB * NH * (SEQ / 256);
    const int per = (NITEMS + G - 1) / G;
    const int it_end = (bx + 1) * per < NITEMS ? (bx + 1) * per : NITEMS;
    for (int it = bx * per; it < it_end; ++it) {
        const int bh = it >> 5, qblk = it & 31, b = bh >> 4, h = bh & 15;
        const int win0 = qblk * 256 - 256;
        __syncthreads();
        {
#pragma unroll
            for (int i = 0; i < 8; ++i) {
                const int slot = w * 64 + i * 8 + (lane >> 3), c = (lane & 7) ^ ((slot >> 1) & 7);
                int kpos = win0 + slot; kpos = kpos < 0 ? 0 : kpos;
                __builtin_amdgcn_global_load_lds((const unsigned*)(Kb + ((size_t)b * SEQ + kpos) * DM + h * 64 + c * 8), (LAS unsigned*)(lds + (w * 64 + i * 8) * 128), 16, 0, 0);
            }
#pragma unroll
            for (int i = 0; i < 8; ++i) {
                const int d = w * 8 + i, kc = lane ^ (d & 15);
                int kpos = win0 + 8 * kc; kpos = kpos < 0 ? 0 : kpos;
                __builtin_amdgcn_global_load_lds((const unsigned*)(VT + (size_t)(h * 64 + d) * M + (size_t)b * SEQ + kpos), (LAS unsigned*)(lds + 65536 + d * 1024), 16, 0, 0);
            }
        }
        const int qb = qblk * 8 + w;
        const size_t tok0 = (size_t)b * SEQ + (size_t)qb * 32;
        const bf16_t* qptr = Q + (tok0 + ql) * DM + h * 64 + 8 * hi;
        bf16x8 qf[4];
#pragma unroll
        for (int ks = 0; ks < 4; ++ks) qf[ks] = *(const bf16x8*)(qptr + 16 * ks);
        asm volatile("s_waitcnt vmcnt(0)" ::: "memory");
        __syncthreads();
        f32x16 o0, o1;
#pragma unroll
        for (int r = 0; r < 16; ++r) { o0[r] = 0.f; o1[r] = 0.f; }
        float carry = 0.f;
        const bf16_t* kbase = Kb + ((size_t)b * SEQ + kperm) * DM + h * 64 + 8 * hi;
        const bf16_t* vbase = VT + (size_t)(h * 64 + ql) * M + (size_t)b * SEQ + 8 * hi;
        for (int kt = qb; kt >= 0; --kt) {
            bf16x8 kf[4], vf[2][2];
            const int kr = kt * 32 - win0;
            if (kr >= 0) {
                const int ksl = kr + kperm, sw = (ksl >> 1) & 7;
                const LAS unsigned char* kl = lds + ksl * 128;
#pragma unroll
                for (int ks = 0; ks < 4; ++ks) kf[ks] = *(const LAS bf16x8*)(kl + (((2 * ks + hi) ^ sw) << 4));
                const int kc0 = (kr >> 3) + hi;
#pragma unroll
                for (int dh = 0; dh < 2; ++dh)
#pragma unroll
                    for (int s = 0; s < 2; ++s) vf[dh][s] = *(const LAS bf16x8*)(lds + 65536 + (dh * 32 + ql) * 1024 + (((kc0 + 2 * s) ^ (ql & 15)) << 4));
            } else {
                const bf16_t* kp = kbase + (size_t)kt * 32 * DM; const bf16_t* vp = vbase + kt * 32;
#pragma unroll
                for (int ks = 0; ks < 4; ++ks) kf[ks] = *(const bf16x8*)(kp + 16 * ks);
#pragma unroll
                for (int dh = 0; dh < 2; ++dh)
#pragma unroll
                    for (int s = 0; s < 2; ++s) vf[dh][s] = *(const bf16x8*)(vp + (size_t)dh * 32 * M + 16 * s);
            }
            f32x16 Sx;
#pragma unroll
            for (int r = 0; r < 16; ++r) Sx[r] = 0.f;
#pragma unroll
            for (int ks = 0; ks < 4; ++ks) Sx = __builtin_amdgcn_mfma_f32_32x32x16_bf16(kf[ks], qf[ks], Sx, 0, 0, 0);
            bf16x8 pf[2];
            if (kt == qb) sb_tile<true>(Sx, carry, hi, ql, pf); else sb_tile<false>(Sx, carry, hi, 0, pf);
#pragma unroll
            for (int s = 0; s < 2; ++s) { o0 = __builtin_amdgcn_mfma_f32_32x32x16_bf16(vf[0][s], pf[s], o0, 0, 0, 0); o1 = __builtin_amdgcn_mfma_f32_32x32x16_bf16(vf[1][s], pf[s], o1, 0, 0, 0); }
            if (__ballot(carry > THR) == 0ull) break;
        }
        bf16_t* op = O + (tok0 + ql) * DM + h * 64 + 4 * hi;
#pragma unroll
        for (int r4 = 0; r4 < 4; ++r4) {
            u32x2 w0; w0.x = cvtpk(o0[4 * r4], o0[4 * r4 + 1]); w0.y = cvtpk(o0[4 * r4 + 2], o0[4 * r4 + 3]);
            u32x2 w1; w1.x = cvtpk(o1[4 * r4], o1[4 * r4 + 1]); w1.y = cvtpk(o1[4 * r4 + 2], o1[4 * r4 + 3]);
            *(u32x2*)(op + 8 * r4) = w0; *(u32x2*)(op + 32 + 8 * r4) = w1;
        }
    }
    __syncthreads();
}

#define XB_TMO      128
#define XB_XCNT(j)  (256  + 64 * (j))
#define XB_XSUB(j)  (1280 + 64 * (j))
#define XB_XGEN(j)  (2304 + 64 * (j))
#define XB_TOP      3328
#define XB_TOPGEN   3392
#define XCD_BAR_WORDS 3456
#define XB_SPIN_CAP (1u << 18)

__device__ __forceinline__ unsigned xb_ld(unsigned* p)              { return __hip_atomic_load(p, __ATOMIC_RELAXED, __HIP_MEMORY_SCOPE_AGENT); }
__device__ __forceinline__ unsigned xb_add(unsigned* p, unsigned v) { return __hip_atomic_fetch_add(p, v, __ATOMIC_RELAXED, __HIP_MEMORY_SCOPE_AGENT); }
__device__ __forceinline__ unsigned xb_xcc_id() { return (unsigned)__builtin_amdgcn_s_getreg((3 << 11) | 20) & 0xFu; }
#define XB_SPIN(cond, bar) do { unsigned _sp = 0; while (cond) { __builtin_amdgcn_s_sleep(1); \
    if ((++_sp & 255u) == 0u) { if (xb_ld(&(bar)[XB_TMO])) break; if (_sp > XB_SPIN_CAP) { atomicAdd(&(bar)[XB_TMO], 1u); break; } } } } while (0)

struct XcdBarrier {
    unsigned* bar; unsigned x;
    volatile LAS unsigned* st;
};

__device__ __forceinline__ XcdBarrier xcd_barrier_post(unsigned* bar, volatile LAS unsigned* st) {
    XcdBarrier b; b.bar = bar; b.x = xb_xcc_id(); b.st = st;
    if (threadIdx.x == 0) (void)xb_add(&bar[XB_XCNT(b.x)], 1u);
    return b;
}
__device__ __forceinline__ void xcd_barrier_complete(unsigned* bar, unsigned x, unsigned& nloc, unsigned& nx) {
    const unsigned G = gridDim.x * gridDim.y * gridDim.z;
    unsigned sum, cnt, mine, sp = 0u;
    for (;;) {
        sum = 0u; cnt = 0u; mine = 0u;
#pragma unroll
        for (unsigned j = 0; j < 16; ++j) { const unsigned c = xb_ld(&bar[XB_XCNT(j)]); sum += c; cnt += (c > 0u) ? 1u : 0u; mine = (j == x) ? c : mine; }
        if (sum == G) break;
        __builtin_amdgcn_s_sleep(1);
        if ((++sp & 255u) == 0u) { if (xb_ld(&bar[XB_TMO])) break; if (sp > XB_SPIN_CAP) { atomicAdd(&bar[XB_TMO], 1u); break; } }
    }
    nloc = mine > 0u ? mine : 1u; nx = cnt > 0u ? cnt : 1u;
}

__device__ __forceinline__ void xcd_barrier(const XcdBarrier& b) {
    asm volatile("s_waitcnt vmcnt(0)" ::: "memory");
    __syncthreads();
    if (threadIdx.x == 0) {
        unsigned* bar = b.bar;
        __builtin_amdgcn_s_waitcnt(0);
        unsigned nloc = b.st[0], nx = b.st[1];
        if (nloc == 0u) { xcd_barrier_complete(bar, b.x, nloc, nx); b.st[0] = nloc; b.st[1] = nx; }
        const unsigned old = xb_add(&bar[XB_XSUB(b.x)], 1u);
        const unsigned gen = old / nloc;
        if (old + 1u == (gen + 1u) * nloc) {
            __builtin_amdgcn_fence(__ATOMIC_RELEASE, "agent");
            asm volatile("s_waitcnt vmcnt(0)" ::: "memory");
            const unsigned og = xb_add(&bar[XB_TOP], 1u);
            const unsigned tg = og / nx;
            if (og + 1u == (tg + 1u) * nx) xb_add(&bar[XB_TOPGEN], 1u);
            else XB_SPIN(xb_ld(&bar[XB_TOPGEN]) == tg, bar);
            __builtin_amdgcn_fence(__ATOMIC_ACQUIRE, "agent");
            xb_add(&bar[XB_XGEN(b.x)], 1u);
            asm volatile("s_waitcnt vmcnt(0)" ::: "memory");
        } else {
            XB_SPIN(xb_ld(&bar[XB_XGEN(b.x)]) == gen, bar);
            __builtin_amdgcn_fence(__ATOMIC_ACQUIRE, "agent");
            asm volatile("s_waitcnt vmcnt(0)" ::: "memory");
        }
    }
    __syncthreads();
}

constexpr int NSTEPS = 16;
__global__ void __launch_bounds__(512, 2) yoco_fwd(Args a_unused) {
    extern __shared__ __attribute__((aligned(16))) unsigned char lds_raw[];
    LAS unsigned char* lds = (LAS unsigned char*)lds_raw;
    const int st_lo = get_args()->st_lo, st_hi = get_args()->st_hi;
    volatile LAS unsigned* MISC = (volatile LAS unsigned*)(lds + RING_BYTES + 4096);
    if (threadIdx.x < 8) MISC[threadIdx.x] = 0u;
    __syncthreads();
    if (st_hi - st_lo > 1 && blockIdx.x == 0) {
        unsigned* bw = (unsigned*)(get_args()->ws + WS_BAR);
        for (int i = threadIdx.x; i < XCD_BAR_WORDS; i += 512) bw[i] = 0u;
    }
    for (int sti = st_lo; sti < st_hi; ++sti) {
        const int st = (sti <= MK_REP) ? sti : sti - 1;
        KArgs ap = get_args();
        unsigned char* ws = ap->ws;
        int tid = threadIdx.x; asm volatile("" : "+v"(tid));
        const int lane = tid & 63, wave = __builtin_amdgcn_readfirstlane(tid >> 6);
        const int G = gridDim.x, bx = blockIdx.x;
        const int gw = bx * 8 + wave, NGW = G * 8;
        if (st == 0) {
            prep_phase(ap, lds, gw, NGW, wave, lane);
        } else if (st == 3) {
            pool_in_phase((const bf16_t*)(ws + WS_HBB), (const float*)(ws + WS_SSB), (bf16_t*)(ws + WS_HBA), gw, NGW, lane);
        } else if (st == 12) {
            attn_phase((const bf16_t*)(ws + WS_HBB), (const bf16_t*)(ws + WS_K), (const bf16_t*)(ws + WS_VT), (bf16_t*)(ws + WS_HID), lds, bx, G, tid);
        } else if (st == 1 || st == 5 || st == 9 || st == 14) {
            const int f = (st == 1) ? 0 : (st == 5) ? 1 : (st == 9) ? 2 : 3;
            const bool useA = (st == 1 || st == 5);
            pg8::Gemm g{(const bf16_t*)(ws + (useA ? WS_HBA : WS_HBB)), (const bf16_t*)(ws + WS_WIN + f * WIN_BYTES), DM, DM, DM, 0};
            pg8::StaticOrder S; S.init(M / 256, NIN / 256, G, bx); S.mode = 1;
            pg8::EpiSwiGLU E{(bf16_t*)(ws + WS_HID), (const float*)(ws + (useA ? WS_SSA : WS_SSB))};
            pg8::gemm_phase(lds, g, S, E, tid);
        } else if (st == 7 || st == 11) {
            const bool isK = (st == 7);
            pg8::Gemm g{(const bf16_t*)(ws + (isK ? WS_HBB : WS_HBA)), (const bf16_t*)(ws + (isK ? WS_WK : WS_WQ)), DM, DM, DM, 0};
            pg8::StaticOrder S; S.init(M / 256, DM / 256, G, bx);
            pg8::EpiHeadNorm E{(bf16_t*)(ws + (isK ? WS_K : WS_HBB)), (const float*)(ws + (isK ? WS_SSB : WS_SSA)), ap->in[isK ? 12 : 15], isK ? 1.0f : 0.125f * LOG2E};
            pg8::gemm_phase(lds, g, S, E, tid);
        } else if (st == 8) {
            pg8::Gemm g{(const bf16_t*)(ws + WS_WV), (const bf16_t*)(ws + WS_HBB), DM, DM, DM, 0};
            pg8::StaticOrder S; S.init(DM / 256, M / 256, G, bx);
            pg8::EpiVT E{(bf16_t*)(ws + WS_VT), (const float*)(ws + WS_SSB)};
            pg8::gemm_phase(lds, g, S, E, tid);
        } else {
            const bool isP = (st == 4), isO = (st == 13), isF = !(isP || isO);
            const int f = (st == 2) ? 0 : (st == 6) ? 1 : (st == 10) ? 2 : 3;
            const bf16_t* gA = (const bf16_t*)(ws + ((isF || isO) ? WS_HID : WS_HBA));
            const bf16_t* gB = (const bf16_t*)(ws + (isP ? WS_WP : isO ? WS_WO : WS_WOUT + f * WOUT_BYTES));
            const int lda = isF ? FF : DM, ldb = isP ? 256 : isO ? DM : FF;
            pg8::Gemm g{gA, gB, lda, ldb, ldb, isP ? 512 : 0};
            const bool toA = (st == 4 || st == 10);
            pg8::StaticOrder S; S.init(M / 256, DM / 256, G, bx);
            const bf16_t* resp = (const bf16_t*)(ws + ((toA || st == 15) ? WS_HBB : WS_HBA));
            if (st == 15) { pg8::EpiRes<true> E{resp, nullptr, ap->out, nullptr}; pg8::gemm_phase(lds, g, S, E, tid); }
            else { pg8::EpiRes<false> E{resp, (bf16_t*)(ws + (toA ? WS_HBA : WS_HBB)), nullptr, (float*)(ws + (toA ? WS_SSA : WS_SSB))}; pg8::gemm_phase(lds, g, S, E, tid); }
        }
        if (sti + 1 < st_hi && st != 7 && st != 8) {
            if (sti == st_lo) { cg::this_grid().sync(); (void)xcd_barrier_post((unsigned*)(ws + WS_BAR), MISC); }
            else { XcdBarrier xb; xb.bar = (unsigned*)(ws + WS_BAR); xb.x = xb_xcc_id(); xb.st = MISC; xcd_barrier(xb); }
        }
    }
}

extern "C" void kernel_launch(void* const* d_in, const int* in_sizes, int n_in, void* d_out, int out_size, void* d_ws, size_t ws_size, hipStream_t stream) {
    static int grid = 0;
    if (grid == 0) {
        if (n_in != 17 || out_size != M * DM || ws_size < WS_END) { fprintf(stderr, "kernel_launch: unexpected shapes (n_in %d out %d ws %zu)\n", n_in, out_size, ws_size); grid = -1; return; }
        int dev = 0, cus = 0, per_cu = 0;
        hipGetDevice(&dev);
        hipDeviceGetAttribute(&cus, hipDeviceAttributeMultiprocessorCount, dev);
        hipFuncSetAttribute((const void*)yoco_fwd, hipFuncAttributeMaxDynamicSharedMemorySize, LDS_BYTES);
        hipOccupancyMaxActiveBlocksPerMultiprocessor(&per_cu, (const void*)yoco_fwd, 512, LDS_BYTES);
        (void)hipGetLastError();
        if (per_cu < 1) per_cu = 1;
        grid = cus * per_cu;
    }
    if (grid < 0) return;
    Args a{};
    for (int i = 0; i < 17; ++i) a.in[i] = (const float*)d_in[i];
    a.out = (float*)d_out; a.ws = (unsigned char*)d_ws;
#if MK_SINGLE
    a.st_lo = 0; a.st_hi = NSTEPS + (MK_REP < NSTEPS ? 1 : 0);
    void* args[] = {&a};
    hipError_t e = hipLaunchCooperativeKernel((const void*)yoco_fwd, dim3(grid), dim3(512), args, LDS_BYTES, stream);
    if (e != hipSuccess) fprintf(stderr, "cooperative launch failed: %s (grid %d)\n", hipGetErrorString(e), grid);
#else
    for (int st = 0; st < NSTEPS; ++st) {
        a.st_lo = st; a.st_hi = st + 1;
        hipLaunchKernelGGL(yoco_fwd, dim3(grid), dim3(512), LDS_BYTES, stream, a);
    }
#endif
}
```

```cpp
#include <hip/hip_runtime.h>
#include <hip/hip_cooperative_groups.h>
#include <cstdio>
#include <cstdint>
namespace cg = cooperative_groups;

#ifndef MK_SINGLE
#define MK_SINGLE 1
#endif

#ifndef MK_REP
#define MK_REP 99
#endif
#define LAS __attribute__((address_space(3)))
typedef unsigned short bf16_t;
typedef short bf16x8 __attribute__((ext_vector_type(8)));
typedef float f32x4 __attribute__((ext_vector_type(4)));
typedef float f32x16 __attribute__((ext_vector_type(16)));
typedef unsigned u32x4 __attribute__((ext_vector_type(4)));
typedef unsigned u32x2 __attribute__((ext_vector_type(2)));
typedef float f32x2_t __attribute__((ext_vector_type(2)));
typedef __bf16 bf16x2_t __attribute__((ext_vector_type(2)));

constexpr int DM = 1024, NB = 8, SEQ = 8192, M = NB * SEQ, NH = 16, HD = 64, FF = 2816, NIN = 2 * FF;
constexpr float EPS = 1e-6f;
constexpr float LOG2E = 1.4426950408889634f, LN2 = 0.6931471805599453f;

constexpr size_t MiB = 1u << 20;
constexpr size_t WS_SSA = 0, WS_SSB = 1 * MiB;
constexpr size_t WS_BAR = 2 * MiB;
constexpr size_t WS_WIN = 4 * MiB, WIN_BYTES = (size_t)NIN * DM * 2;
constexpr size_t WS_WOUT = 48 * MiB, WOUT_BYTES = (size_t)DM * FF * 2;
constexpr size_t WS_WK = 70 * MiB, WS_WV = 72 * MiB, WS_WQ = 74 * MiB, WS_WO = 76 * MiB, WS_WP = 78 * MiB;
constexpr size_t WS_HBA = 80 * MiB, WS_HBB = 208 * MiB;
constexpr size_t WS_HID = 336 * MiB;
constexpr size_t WS_K = 688 * MiB, WS_VT = 816 * MiB, WS_END = 944 * MiB;
static_assert(WS_WIN + 4 * WIN_BYTES <= WS_WOUT && WS_WOUT + 4 * WOUT_BYTES <= WS_WK, "ws map");
static_assert(WS_HID + (size_t)M * FF * 2 <= WS_K, "ws map");

constexpr int RING_BYTES = 131072, SCR_OFF = RING_BYTES, SS_OFF = RING_BYTES + 8192, LDS_BYTES = RING_BYTES + 16384;

__device__ __forceinline__ unsigned cvtpk(float lo, float hi) { f32x2_t v = {lo, hi}; bf16x2_t b = __builtin_convertvector(v, bf16x2_t); return __builtin_bit_cast(unsigned, b); }
__device__ __forceinline__ float rstd_from(const f32x4 s) { float a = s[0] + s[1], b = s[2] + s[3]; asm volatile("" : "+v"(a), "+v"(b));
    return __builtin_amdgcn_rsqf((a + b) * (1.0f / DM) + EPS); }

__device__ __forceinline__ f32x4 zero4() {
    typedef unsigned long long u64x2 __attribute__((ext_vector_type(2)));
    unsigned long long a, b; asm volatile("v_mov_b64 %0, 0\n\tv_mov_b64 %1, 0" : "=v"(a), "=v"(b));
    u64x2 v = {a, b}; return __builtin_bit_cast(f32x4, v);
}
namespace pg8 {
constexpr int BM = 256, BK = 64, HALF = 128, HTB = HALF * BK * 2, NXCD = 8, WGM = 8;
__device__ __forceinline__ int lds_byte(int r, int c) { const int st = (r >> 4) * 2 + (c >> 5), rr = r & 15, cc = c & 31, ob = rr * 64 + cc * 2; return st * 1024 + (ob ^ (((ob >> 9) & 1) << 5)); }
__device__ __forceinline__ void stage_rc(int b, int& R, int& C) { const int st = b / 1024, sb = b % 1024, swz = sb ^ (((sb >> 9) & 1) << 5); R = (st >> 1) * 16 + swz / 64; C = (st & 1) * 32 + (swz % 64) / 2; }
__device__ __forceinline__ int perm32(int rho) { const int n = rho >> 4, i = rho & 15; return 8 * (i >> 2) + 4 * n + (i & 3); }

struct Unit { int pm, pn; };
struct Gemm { const bf16_t* A; const bf16_t* Bt; int lda, ldb, K, a_pn_bytes; };

struct StaticOrder {
    int nM, nN, nwg, G, c, mode = 0;
    __device__ __forceinline__ void init(int nM_, int nN_, int G_, int c_) { nM = nM_; nN = nN_; nwg = nM * nN; G = G_; c = c_; }
    __device__ __forceinline__ bool next(int i, Unit& u) const {
        const long L = (long)i * G + c; if (L >= nwg) return false;
        int wgid = (int)L;
        if (mode == 3) {
            const int w2 = (wgid & 7) * 128 + (wgid >> 3), r32 = w2 & 31; u.pm = (w2 >> 5) * 8 + (r32 & 7); u.pn = r32 >> 3; return true;
        }
        if (mode == 4) {
            const int w2 = (wgid & 7) * 128 + (wgid >> 3); u.pm = w2 & 3; u.pn = w2 >> 2; return true;
        }
        if (mode == 1) {
            const int xcd = wgid & 7, p = wgid >> 3; int pml, pn;
            if (p < 640) { const int j = p >> 7, rem = p & 127, b = rem >> 5, k = rem & 31; pml = 8 * b + (k & 7); pn = 4 * j + (k >> 3); }
            else { const int pp = p - 640, b = pp >> 4, k = pp & 15; pml = 8 * b + (k & 7); pn = 20 + (k >> 3); }
            u.pm = 32 * xcd + pml; u.pn = pn; return true;
        } { const int q = nwg / NXCD, r = nwg % NXCD, xcd = wgid % NXCD, off = wgid / NXCD; wgid = (xcd < r ? xcd * (q + 1) : r * (q + 1) + (xcd - r) * q) + off; }
        const int nig = WGM * nN, gid = wgid / nig, fm = gid * WGM, gsz = (nM - fm) < WGM ? (nM - fm) : WGM;
        u.pm = fm + ((wgid % nig) % gsz); u.pn = (wgid % nig) / gsz; return true;
    }
};


struct EpiSwiGLU {
    static constexpr int SS_STAGE = 1;
    bf16_t* H; const float* ss4;
    __device__ __forceinline__ void operator()(const f32x4 (&acc)[2][2][4][2], const Unit& u, int wr, int wc, int fr, int fq, int tid, LAS float* scr, int sbuf) const {
        const int row0 = u.pm * BM + wr * 64 + fr, col0 = u.pn * 128 + wc * 32 + 8 * fq;
        f32x4 sv[2][4];
#pragma unroll
        for (int ai = 0; ai < 2; ++ai)
#pragma unroll
            for (int m = 0; m < 4; ++m) sv[ai][m] = *(const LAS f32x4*)((const LAS unsigned char*)scr + 8192 + sbuf * 4096 + (ai * HALF + wr * 64 + m * 16 + fr) * 16);
#pragma unroll
        for (int ai = 0; ai < 2; ++ai)
#pragma unroll
            for (int m = 0; m < 4; ++m) {
                const int row = row0 + ai * HALF + m * 16;
                const float rs = rstd_from(sv[ai][m]), rs2 = rs * (-LOG2E), irsq = __builtin_amdgcn_rcpf(rs * rs);
                float o[8];
#pragma unroll
                for (int n = 0; n < 2; ++n)
#pragma unroll
                    for (int p = 0; p < 2; ++p) {
                        const f32x2_t ag = {acc[ai][0][m][n][2 * p], acc[ai][0][m][n][2 * p + 1]}, au = {acc[ai][1][m][n][2 * p], acc[ai][1][m][n][2 * p + 1]};
                        const f32x2_t t = ag * rs2;
                        f32x2_t d; d.x = __builtin_amdgcn_exp2f(t.x); d.y = __builtin_amdgcn_exp2f(t.y); d = d * irsq + irsq;
                        f32x2_t r; r.x = __builtin_amdgcn_rcpf(d.x); r.y = __builtin_amdgcn_rcpf(d.y);
                        const f32x2_t res = (ag * au) * r;
                        o[n * 4 + 2 * p] = res.x; o[n * 4 + 2 * p + 1] = res.y;
                    }
                u32x4 w; w.x = cvtpk(o[0], o[1]); w.y = cvtpk(o[2], o[3]); w.z = cvtpk(o[4], o[5]); w.w = cvtpk(o[6], o[7]);
                *(u32x4*)(H + (size_t)row * FF + col0) = w;
            }
    }
};

__device__ __forceinline__ void unpack8v(const u32x4 p, f32x4& a, f32x4& b) {
    a[0] = __builtin_bit_cast(float, p[0] << 16); a[1] = __builtin_bit_cast(float, p[0] & 0xffff0000u); a[2] = __builtin_bit_cast(float, p[1] << 16); a[3] = __builtin_bit_cast(float, p[1] & 0xffff0000u);
    b[0] = __builtin_bit_cast(float, p[2] << 16); b[1] = __builtin_bit_cast(float, p[2] & 0xffff0000u); b[2] = __builtin_bit_cast(float, p[3] << 16); b[3] = __builtin_bit_cast(float, p[3] & 0xffff0000u);
}
template <bool FIN> struct EpiRes {
    static constexpr int SS_STAGE = 0;
    const bf16_t* res; bf16_t* outb; float* outf; float* ss4;
    __device__ __forceinline__ void operator()(const f32x4 (&acc)[2][2][4][2], const Unit& u, int wr, int wc, int fr, int fq, int tid, LAS float* scr, int sbuf) const {
        const int row0 = u.pm * BM + wr * 64 + fr, col0 = u.pn * BM + wc * 32 + 8 * fq;
        u32x4 rv[2][4][2];
#pragma unroll
        for (int ai = 0; ai < 2; ++ai)
#pragma unroll
            for (int m = 0; m < 4; ++m)
#pragma unroll
                for (int bj = 0; bj < 2; ++bj) rv[ai][m][bj] = *(const u32x4*)(res + (size_t)(row0 + ai * HALF + m * 16) * DM + col0 + bj * HALF);
        float s8[8];
#pragma unroll
        for (int ai = 0; ai < 2; ++ai) {
#pragma unroll
            for (int m = 0; m < 4; ++m) {
                const int row = row0 + ai * HALF + m * 16; f32x2_t sq = {0.f, 0.f};
#pragma unroll
                for (int bj = 0; bj < 2; ++bj) {
                    const size_t off = (size_t)row * DM + col0 + bj * HALF;
                    const u32x4 p = rv[ai][m][bj]; f32x2_t v[4];
#pragma unroll
                    for (int q = 0; q < 4; ++q) {
                        const f32x2_t r = {__builtin_bit_cast(float, p[q] << 16), __builtin_bit_cast(float, p[q] & 0xffff0000u)};
                        const f32x2_t a = {acc[ai][bj][m][q >> 1][2 * (q & 1)], acc[ai][bj][m][q >> 1][2 * (q & 1) + 1]};
                        v[q] = r + a; if (!FIN) sq = v[q] * v[q] + sq;
                    }
                    if (FIN) { *(f32x4*)(outf + off) = (f32x4){v[0].x, v[0].y, v[1].x, v[1].y}; *(f32x4*)(outf + off + 4) = (f32x4){v[2].x, v[2].y, v[3].x, v[3].y}; }
                    else { u32x4 w; w.x = cvtpk(v[0].x, v[0].y); w.y = cvtpk(v[1].x, v[1].y); w.z = cvtpk(v[2].x, v[2].y); w.w = cvtpk(v[3].x, v[3].y); *(u32x4*)(outb + off) = w; }
                }
                s8[ai * 4 + m] = sq.x + sq.y;
            }
        }
        if (!FIN) {
            float t8[8];
#pragma unroll
            for (int i = 0; i < 8; ++i) t8[i] = __shfl_xor(s8[i], 16);
#pragma unroll
            for (int i = 0; i < 8; ++i) s8[i] += t8[i];
#pragma unroll
            for (int i = 0; i < 8; ++i) t8[i] = __shfl_xor(s8[i], 32);
#pragma unroll
            for (int i = 0; i < 8; ++i) if (fq == 0) scr[((i >> 2) * HALF + wr * 64 + (i & 3) * 16 + fr) * 4 + wc] = s8[i] + t8[i];
            asm volatile("s_waitcnt lgkmcnt(0)" ::: "memory"); __builtin_amdgcn_s_barrier(); asm volatile("" ::: "memory");
            if (tid < 256) { const f32x4 p = *(const LAS f32x4*)(scr + tid * 4); ss4[(size_t)(u.pm * BM + tid) * 4 + u.pn] = (p[0] + p[1]) + (p[2] + p[3]); }
        }
    }
};

struct EpiHeadNorm {
    static constexpr int SS_STAGE = 1;
    bf16_t* O; const float* ss4; const float* gain; float oscale;
    __device__ __forceinline__ void operator()(const f32x4 (&acc)[2][2][4][2], const Unit& u, int wr, int wc, int fr, int fq, int tid, LAS float* scr, int sbuf) const {
        const int row0 = u.pm * BM + wr * 64 + fr, colh = (u.pn * 4 + wc) * 64 + 8 * fq;
        f32x4 gv[2][2];
#pragma unroll
        for (int bj = 0; bj < 2; ++bj)
#pragma unroll
            for (int n = 0; n < 2; ++n) gv[bj][n] = *(const f32x4*)(gain + 32 * bj + 8 * fq + 4 * n);
        float s8[8], rs8[8];
#pragma unroll
        for (int ai = 0; ai < 2; ++ai)
#pragma unroll
            for (int m = 0; m < 4; ++m) {
                rs8[ai * 4 + m] = rstd_from(*(const LAS f32x4*)((const LAS unsigned char*)scr + 8192 + sbuf * 4096 + (ai * HALF + wr * 64 + m * 16 + fr) * 16));
                f32x4 q = acc[ai][0][m][0] * acc[ai][0][m][0]; q = acc[ai][0][m][1] * acc[ai][0][m][1] + q; q = acc[ai][1][m][0] * acc[ai][1][m][0] + q; q = acc[ai][1][m][1] * acc[ai][1][m][1] + q;
                s8[ai * 4 + m] = (q[0] + q[1]) + (q[2] + q[3]);
            }
        float t8[8];
#pragma unroll
        for (int i = 0; i < 8; ++i) t8[i] = __shfl_xor(s8[i], 16);
#pragma unroll
        for (int i = 0; i < 8; ++i) s8[i] += t8[i];
#pragma unroll
        for (int i = 0; i < 8; ++i) t8[i] = __shfl_xor(s8[i], 32);
#pragma unroll
        for (int ai = 0; ai < 2; ++ai)
#pragma unroll
            for (int m = 0; m < 4; ++m) {
                const int i = ai * 4 + m, row = row0 + ai * HALF + m * 16;
                const float rs = rs8[i], hr = rs * __builtin_amdgcn_rsqf((s8[i] + t8[i]) * (rs * rs) * (1.0f / HD) + EPS) * oscale;
#pragma unroll
                for (int bj = 0; bj < 2; ++bj) {
                    const f32x4 a = acc[ai][bj][m][0] * gv[bj][0] * hr, b = acc[ai][bj][m][1] * gv[bj][1] * hr;
                    u32x4 w; w.x = cvtpk(a[0], a[1]); w.y = cvtpk(a[2], a[3]); w.z = cvtpk(b[0], b[1]); w.w = cvtpk(b[2], b[3]);
                    *(u32x4*)(O + (size_t)row * DM + colh + 32 * bj) = w;
                }
            }
    }
};

struct EpiVT {
    static constexpr int SS_STAGE = 2;
    bf16_t* VT; const float* ss4;
    __device__ __forceinline__ void operator()(const f32x4 (&acc)[2][2][4][2], const Unit& u, int wr, int wc, int fr, int fq, int tid, LAS float* scr, int sbuf) const {
        const int row0 = u.pm * BM + wr * 64 + fr, col0 = u.pn * BM + wc * 32 + 8 * fq;
        float rs[2][8];
#pragma unroll
        for (int bj = 0; bj < 2; ++bj)
#pragma unroll
            for (int j = 0; j < 8; ++j) rs[bj][j] = rstd_from(*(const LAS f32x4*)((const LAS unsigned char*)scr + 8192 + sbuf * 4096 + (bj * HALF + wc * 32 + 8 * fq + j) * 16));
#pragma unroll
        for (int ai = 0; ai < 2; ++ai)
#pragma unroll
            for (int m = 0; m < 4; ++m) {
                const int row = row0 + ai * HALF + m * 16;
#pragma unroll
                for (int bj = 0; bj < 2; ++bj) {
                    const f32x4 a = acc[ai][bj][m][0], b = acc[ai][bj][m][1];
                    u32x4 w; w.x = cvtpk(a[0] * rs[bj][0], a[1] * rs[bj][1]); w.y = cvtpk(a[2] * rs[bj][2], a[3] * rs[bj][3]);
                    w.z = cvtpk(b[0] * rs[bj][4], b[1] * rs[bj][5]); w.w = cvtpk(b[2] * rs[bj][6], b[3] * rs[bj][7]);
                    *(u32x4*)(VT + (size_t)row * M + col0 + bj * HALF) = w;
                }
            }
    }
};

template <class Epi>
__device__ __forceinline__ void gemm_phase(LAS unsigned char* lds, const Gemm g, const StaticOrder& S, const Epi& E, const int tid) {
    const int wid = __builtin_amdgcn_readfirstlane(tid >> 6), lane = tid & 63, wr = wid >> 2, wc = wid & 3, fr = lane & 15, fq = lane >> 4;
    const int K = g.K, nt = K / BK;
    unsigned voffA[2], voffB[2];
#pragma unroll
    for (int i = 0; i < 2; ++i) { int R, C; stage_rc(tid * 16 + i * 8192, R, C); const int Rb = (R & ~31) + perm32(R & 31);
        voffA[i] = (unsigned)(R * g.lda + C) * 2u; voffB[i] = (unsigned)(Rb * g.ldb + C) * 2u; }
    const size_t kstep = (size_t)(BK * 2);
    const size_t hstepA = (size_t)HALF * g.lda * 2, hstepB = (size_t)HALF * g.ldb * 2;
    const size_t tstepA = 2 * hstepA, tstepB = 2 * hstepB;
    const unsigned ldsw = (unsigned)wid * 1024u;
    const int aoff = lds_byte(wr * 64 + fr, fq * 8), boff = lds_byte(wc * 32 + fr, fq * 8);
#define PG8_SA(b, h) (((b) * 2 + (h)) * HTB)
#define PG8_SB(b, h) ((4 + (b) * 2 + (h)) * HTB)
#define PG8_STAGE(bufoff, gbase, voff) do { _Pragma("unroll") for (int _i = 0; _i < 2; ++_i) \
        __builtin_amdgcn_global_load_lds((const unsigned*)((const char*)(gbase) + (voff)[_i]), (LAS unsigned*)(lds + (bufoff) + ldsw + _i * 8192), 16, 0, 0); } while (0)
#define PG8_LDA(dst, b, h) do { _Pragma("unroll") for (int m = 0; m < 4; ++m) _Pragma("unroll") for (int k = 0; k < 2; ++k) dst[m][k] = *(const LAS bf16x8*)(lds + PG8_SA(b, h) + aoff + m * 2048 + k * 1024); } while (0)
#define PG8_LDB(dst, b, h) do { _Pragma("unroll") for (int n = 0; n < 2; ++n) _Pragma("unroll") for (int k = 0; k < 2; ++k) dst[n][k] = *(const LAS bf16x8*)(lds + PG8_SB(b, h) + boff + n * 2048 + k * 1024); } while (0)
#define PG8_MMA(ai, bj, At, Bt) do { __builtin_amdgcn_s_setprio(1); _Pragma("unroll") for (int m = 0; m < 4; ++m) _Pragma("unroll") for (int n = 0; n < 2; ++n) _Pragma("unroll") for (int k = 0; k < 2; ++k) \
        acc[ai][bj][m][n] = __builtin_amdgcn_mfma_f32_16x16x32_bf16(Bt[n][k], At[m][k], acc[ai][bj][m][n], 0, 0, 0); __builtin_amdgcn_s_setprio(0); } while (0)
#define PG8_WAIT_V(n) asm volatile("s_waitcnt vmcnt(" #n ")" ::: "memory")
#define PG8_WAIT_L(n) asm volatile("s_waitcnt lgkmcnt(" #n ")" ::: "memory")
#define PG8_BAR __builtin_amdgcn_s_barrier()
#define PG8_SCHED __builtin_amdgcn_sched_barrier(0)
    Unit cur, nxt; int ui = 0;
    if (!S.next(0, cur)) return;
#define PG8_SS_PREFETCH(U, BUF) do { if (Epi::SS_STAGE != 0 && wid < 4) { const char* sb_ = (const char*)E.ss4 + (size_t)((Epi::SS_STAGE == 2 ? (U).pn : (U).pm) * BM + wid * 64) * 16; \
        __builtin_amdgcn_global_load_lds((const unsigned*)(sb_ + (unsigned)lane * 16u), (LAS unsigned*)(lds + SS_OFF + (BUF) * 4096 + wid * 1024), 16, 0, 0); } } while (0)
    PG8_SS_PREFETCH(cur, 0);
    f32x4 acc[2][2][4][2];
#pragma unroll
    for (int a = 0; a < 2; ++a)
#pragma unroll
        for (int b = 0; b < 2; ++b)
#pragma unroll
            for (int m = 0; m < 4; ++m)
#pragma unroll
                for (int n = 0; n < 2; ++n) acc[a][b][m][n] = zero4();
    bf16x8 At[4][2], B0[2][2], B1[2][2];
    const char* cA = (const char*)g.A + (size_t)cur.pm * tstepA + (size_t)cur.pn * g.a_pn_bytes; const char* cB = (const char*)g.Bt + (size_t)cur.pn * tstepB;
    PG8_STAGE(PG8_SB(0, 0), cB, voffB); PG8_STAGE(PG8_SB(0, 1), cB + hstepB, voffB); PG8_STAGE(PG8_SA(0, 0), cA, voffA); PG8_STAGE(PG8_SA(0, 1), cA + hstepA, voffA);
    if (wr == 1) PG8_BAR;
    PG8_WAIT_V(2); PG8_BAR;
    PG8_STAGE(PG8_SB(1, 0), cB + kstep, voffB); PG8_STAGE(PG8_SA(1, 0), cA + kstep, voffA); PG8_STAGE(PG8_SB(1, 1), cB + hstepB + kstep, voffB);
    PG8_WAIT_V(6); PG8_BAR;
    for (;;) {
        const bool has_next = S.next(ui + 1, nxt);
        const char* nA = has_next ? (const char*)g.A + (size_t)nxt.pm * tstepA + (size_t)nxt.pn * g.a_pn_bytes : cA; const char* nB = has_next ? (const char*)g.Bt + (size_t)nxt.pn * tstepB : cB;
        for (int t = 0; t < nt; t += 2) {
            const bool last = (t == nt - 2);
            const char* a1 = cA + (size_t)(t + 1) * kstep;
            const char* a2 = last ? nA : cA + (size_t)(t + 2) * kstep; const char* b2 = last ? nB : cB + (size_t)(t + 2) * kstep;
            const char* a3 = a2 + kstep; const char* b3 = b2 + kstep;
            PG8_LDB(B0, 0, 0); PG8_LDB(B1, 0, 1); PG8_SCHED; PG8_LDA(At, 0, 0); PG8_STAGE(PG8_SA(1, 1), a1 + hstepA, voffA);
            PG8_WAIT_V(8); PG8_WAIT_L(0); PG8_BAR; PG8_MMA(0, 0, At, B0); PG8_MMA(0, 1, At, B1); PG8_BAR; PG8_SCHED;
            PG8_LDA(At, 0, 1); PG8_STAGE(PG8_SB(0, 0), b2, voffB); PG8_STAGE(PG8_SB(0, 1), b2 + hstepB, voffB); PG8_STAGE(PG8_SA(0, 0), a2, voffA);
            PG8_WAIT_V(8); PG8_WAIT_L(0); PG8_BAR; PG8_MMA(1, 0, At, B0); PG8_MMA(1, 1, At, B1); PG8_BAR; PG8_SCHED;
            PG8_LDB(B0, 1, 0); PG8_LDB(B1, 1, 1); PG8_SCHED; PG8_LDA(At, 1, 0); PG8_STAGE(PG8_SA(0, 1), a2 + hstepA, voffA);
            PG8_WAIT_V(8); PG8_WAIT_L(0); PG8_BAR; PG8_MMA(0, 0, At, B0); PG8_MMA(0, 1, At, B1); PG8_BAR; PG8_SCHED;
            PG8_LDA(At, 1, 1); PG8_STAGE(PG8_SB(1, 0), b3, voffB); PG8_STAGE(PG8_SB(1, 1), b3 + hstepB, voffB); PG8_STAGE(PG8_SA(1, 0), a3, voffA);
            PG8_WAIT_V(8); PG8_WAIT_L(0); PG8_BAR; PG8_MMA(1, 0, At, B0); PG8_MMA(1, 1, At, B1); PG8_BAR; PG8_SCHED;
        }
        if (wr == 0) PG8_BAR;
        E(acc, cur, wr, wc, fr, fq, tid, (LAS float*)(lds + 131072), ui & 1);
        if (!has_next) break;
        PG8_SS_PREFETCH(nxt, (ui + 1) & 1);
#pragma unroll
        for (int a = 0; a < 2; ++a)
#pragma unroll
            for (int b = 0; b < 2; ++b)
#pragma unroll
                for (int m = 0; m < 4; ++m)
#pragma unroll
                    for (int n = 0; n < 2; ++n) acc[a][b][m][n] = zero4();
        cur = nxt; cA = nA; cB = nB; ++ui;
        if (wr == 1) PG8_BAR;
    }
    PG8_WAIT_V(0);
    PG8_BAR;
#undef PG8_SA
#undef PG8_SB
#undef PG8_STAGE
#undef PG8_LDA
#undef PG8_LDB
#undef PG8_MMA
#undef PG8_WAIT_V
#undef PG8_WAIT_L
#undef PG8_BAR
#undef PG8_SCHED
#undef PG8_SS_PREFETCH
}
}

__device__ __forceinline__ void tr_item(const float* W, int ldn, int k0, int n0, const float* gk, const float* cs, bf16_t* WT, int ldk, int drow0, LAS float* scr, int lane, float mul = 1.f) {
    const int n = lane & 31, kh = lane >> 5;
    const float csn = (cs ? cs[n0 + n] : 1.f) * mul;
    float wv[32];
#pragma unroll
    for (int i = 0; i < 32; ++i) wv[i] = W[(size_t)(k0 + 2 * i + kh) * ldn + n0 + n];
#pragma unroll
    for (int i = 0; i < 32; ++i) { const int kk = 2 * i + kh; const float gg = gk ? gk[k0 + kk] : 1.f; scr[kk * 33 + n] = wv[i] * gg * csn; }
    asm volatile("s_waitcnt lgkmcnt(0)" ::: "memory");
    const int c = lane & 7;
#pragma unroll
    for (int j = 0; j < 4; ++j) { const int nn = (lane >> 3) + 8 * j; const LAS float* s = scr + (8 * c) * 33 + nn;
        u32x4 o; o.x = cvtpk(s[0 * 33], s[1 * 33]); o.y = cvtpk(s[2 * 33], s[3 * 33]); o.z = cvtpk(s[4 * 33], s[5 * 33]); o.w = cvtpk(s[6 * 33], s[7 * 33]);
        *(u32x4*)(WT + (size_t)(drow0 + nn) * ldk + k0 + 8 * c) = o; }
    asm volatile("s_waitcnt lgkmcnt(0)" ::: "memory");
}

struct Args { const float* in[17]; float* out; unsigned char* ws; int st_lo, st_hi; };

typedef const __attribute__((address_space(4))) Args* KArgs;
__device__ __forceinline__ KArgs get_args() { const __attribute__((address_space(4))) void* p = (const __attribute__((address_space(4))) void*)__builtin_amdgcn_kernarg_segment_ptr(); asm volatile("" : "+s"(p)); return (KArgs)p; }
__device__ __forceinline__ void prep_phase(KArgs ap, LAS unsigned char* lds, int gw, int NGW, int wave, int lane) {
    LAS float* scr = (LAS float*)(lds + wave * 16384);
    unsigned char* ws = ap->ws;
    constexpr int I_IN = (DM / 64) * (NIN / 32);
    constexpr int I_OUT = (FF / 64) * (DM / 32);
    constexpr int I_SQ = (DM / 64) * (DM / 32);
    constexpr int I_P = 4 * (256 / 64) * (256 / 32);
    constexpr int NITEMS = 4 * I_IN + 4 * I_OUT + 4 * I_SQ + I_P;
    for (int it = gw; it < NITEMS; it += NGW) {
        int r = it;
        if (r < 4 * I_IN) {
            const int f = r / I_IN; r -= f * I_IN; const int l = f >> 1;
            const float* W = ap->in[(f & 1) ? 5 : 2] + (size_t)l * DM * NIN; const float* gk = ap->in[(f & 1) ? 4 : 1] + l * DM;
            const int nblk = NIN / 32, kb = r / nblk, db = r % nblk, R = 32 * db, pn = R >> 8, bj = (R >> 7) & 1, j = R & 127;
            tr_item(W, NIN, 64 * kb, bj * FF + 128 * pn + j, gk, nullptr, (bf16_t*)(ws + WS_WIN + f * WIN_BYTES), DM, R, scr, lane);
            continue;
        }
        r -= 4 * I_IN;
        if (r < 4 * I_OUT) {
            const int f = r / I_OUT; r -= f * I_OUT; const int l = f >> 1;
            const float* W = ap->in[(f & 1) ? 6 : 3] + (size_t)l * FF * DM;
            const int nblk = DM / 32, kb = r / nblk, db = r % nblk;
            tr_item(W, DM, 64 * kb, 32 * db, nullptr, nullptr, (bf16_t*)(ws + WS_WOUT + f * WOUT_BYTES), FF, 32 * db, scr, lane, 0.5f);
            continue;
        }
        r -= 4 * I_OUT;
        if (r < 4 * I_SQ) {
            const int q = r / I_SQ; r -= q * I_SQ; const int kb = r / 32, db = r % 32, R = 32 * db;
            const int srcp = (R & ~255) + 64 * ((R >> 5) & 3) + 32 * ((R >> 7) & 1);
            if (q == 0)      tr_item(ap->in[11], 2 * DM, 64 * kb, srcp, ap->in[10], nullptr, (bf16_t*)(ws + WS_WK), DM, R, scr, lane);
            else if (q == 1) tr_item(ap->in[11], 2 * DM, 64 * kb, DM + R, ap->in[10], nullptr, (bf16_t*)(ws + WS_WV), DM, R, scr, lane);
            else if (q == 2) tr_item(ap->in[14], DM, 64 * kb, srcp, ap->in[13], nullptr, (bf16_t*)(ws + WS_WQ), DM, R, scr, lane);
            else             tr_item(ap->in[16], DM, 64 * kb, R, nullptr, nullptr, (bf16_t*)(ws + WS_WO), DM, R, scr, lane);
            continue;
        }
        r -= 4 * I_SQ;
        { const int gI = r / 32; r -= gI * 32; const int kb = r / 8, db = r % 8;
          tr_item(ap->in[8] + (size_t)gI * 65536, 256, 64 * kb, 32 * db, ap->in[7] + gI * 256, ap->in[9] + gI * 256, (bf16_t*)(ws + WS_WP) + (size_t)gI * 65536, 256, 32 * db, scr, lane); }
    }
    const float* x = ap->in[0]; bf16_t* xb = (bf16_t*)(ws + WS_HBA); float* ss = (float*)(ws + WS_SSA);
    for (int m0 = gw * 4; m0 < M; m0 += NGW * 4) {
        f32x4 v[4][4]; float sq[4];
#pragma unroll
        for (int rr = 0; rr < 4; ++rr) { const f32x4* xr = (const f32x4*)(x + (size_t)(m0 + rr) * DM) + lane;
#pragma unroll
            for (int j = 0; j < 4; ++j) v[rr][j] = xr[64 * j]; }
#pragma unroll
        for (int rr = 0; rr < 4; ++rr) { float s = 0.f;
#pragma unroll
            for (int j = 0; j < 4; ++j) s += (v[rr][j][0] * v[rr][j][0] + v[rr][j][1] * v[rr][j][1]) + (v[rr][j][2] * v[rr][j][2] + v[rr][j][3] * v[rr][j][3]);
            sq[rr] = s; }
#pragma unroll
        for (int o = 1; o < 64; o <<= 1) {
#pragma unroll
            for (int rr = 0; rr < 4; ++rr) sq[rr] += __shfl_xor(sq[rr], o); }
#pragma unroll
        for (int rr = 0; rr < 4; ++rr) { u32x2* o8 = (u32x2*)(xb + (size_t)(m0 + rr) * DM) + lane;
#pragma unroll
            for (int j = 0; j < 4; ++j) { u32x2 w; w.x = cvtpk(v[rr][j][0], v[rr][j][1]); w.y = cvtpk(v[rr][j][2], v[rr][j][3]); o8[64 * j] = w; }
            if (lane == 0) *(f32x4*)(ss + (size_t)(m0 + rr) * 4) = (f32x4){sq[rr], 0.f, 0.f, 0.f}; }
    }
}

__device__ __forceinline__ void unpack8(const u32x4 p, float (&f)[8]) {
#pragma unroll
    for (int i = 0; i < 4; ++i) { f[2 * i] = __builtin_bit_cast(float, p[i] << 16); f[2 * i + 1] = __builtin_bit_cast(float, p[i] & 0xffff0000u); }
}
__device__ __forceinline__ void pool_in_phase(const bf16_t* __restrict__ hb, const float* __restrict__ ss4, bf16_t* __restrict__ P, int gw, int NGW, int lane) {
    const int NITEMS = (M / 32) * 2;
    for (int it = gw; it < NITEMS; it += NGW) {
        const int chunk = it >> 1, strip = it & 1, t0 = chunk * 32, pos0 = t0 & (SEQ - 1);
        float rs = 0.f;
        if (lane < 48 && pos0 + lane - 16 >= 0) rs = rstd_from(*(const f32x4*)(ss4 + (size_t)(t0 - 16 + lane) * 4));
        const int c0 = strip * 512 + lane * 8, w = 2 << (c0 >> 8);
        float S[8];
#pragma unroll
        for (int e = 0; e < 8; ++e) S[e] = 0.f;
#pragma unroll
        for (int j = 1; j <= 16; ++j) {
            const float rj = __shfl(rs, 16 - j);
            if (j <= w && pos0 - j >= 0) { float f[8]; unpack8(*(const u32x4*)(hb + (size_t)(t0 - j) * DM + c0), f);
#pragma unroll
                for (int e = 0; e < 8; ++e) S[e] += f[e] * rj; }
        }
        for (int ib = 0; ib < 4; ++ib) {
            u32x4 xn[8], xo[8];
#pragma unroll
            for (int k = 0; k < 8; ++k) { const int i = ib * 8 + k, t = t0 + i; const bool has = (pos0 + i >= w);
                xn[k] = *(const u32x4*)(hb + (size_t)t * DM + c0); xo[k] = *(const u32x4*)(hb + (size_t)(has ? t - w : t) * DM + c0); }
#pragma unroll
            for (int k = 0; k < 8; ++k) {
                const int i = ib * 8 + k, t = t0 + i, pos = pos0 + i;
                const float rt = __shfl(rs, 16 + i); float ro = __shfl(rs, 16 + i - w); ro = (pos >= w) ? ro : 0.f;
                float xs[8], f[8]; unpack8(xn[k], xs); unpack8(xo[k], f);
#pragma unroll
                for (int e = 0; e < 8; ++e) { xs[e] *= rt; S[e] += xs[e]; S[e] -= f[e] * ro; }
                const int cnt = (pos + 1 < w) ? pos + 1 : w; const float ic = __builtin_amdgcn_rcpf((float)cnt);
                u32x4 o; o.x = cvtpk(S[0] * ic - xs[0], S[1] * ic - xs[1]); o.y = cvtpk(S[2] * ic - xs[2], S[3] * ic - xs[3]);
                o.z = cvtpk(S[4] * ic - xs[4], S[5] * ic - xs[5]); o.w = cvtpk(S[6] * ic - xs[6], S[7] * ic - xs[7]);
                *(u32x4*)(P + (size_t)t * DM + c0) = o;
            }
        }
    }
}

__device__ __forceinline__ float xchg32(float v, int hi) {
    const unsigned u = __builtin_bit_cast(unsigned, v);
    const auto r = __builtin_amdgcn_permlane32_swap(u, u, false, false);
    return __builtin_bit_cast(float, hi ? r[0] : r[1]);
}
template <bool MASK>
__device__ __forceinline__ void sb_tile(const f32x16& Sx, float& carry, int hi, int qlim, bf16x8 (&pf)[2]) {
    float L[16];
#pragma unroll
    for (int r = 0; r < 16; ++r) {
        const float z = Sx[r];
        const float e = __builtin_amdgcn_exp2f(-__builtin_fabsf(z));
        const float sp = __builtin_fmaf(0.5f, z, __builtin_fmaf(0.5f, __builtin_fabsf(z), __builtin_amdgcn_logf(1.0f + e)));
        if (MASK) { const int kk = 16 * (r >> 3) + 8 * hi + (r & 7); L[r] = (kk < qlim) ? -sp : 0.f; } else L[r] = -sp;
    }
    float suf[16];
    suf[7] = L[7]; suf[15] = L[15];
#pragma unroll
    for (int r = 6; r >= 0; --r) { suf[r] = L[r] + suf[r + 1]; suf[8 + r] = L[8 + r] + suf[9 + r]; }
    const float T0 = suf[0], T1 = suf[8];
    const float T0p = xchg32(T0, hi), T1p = xchg32(T1, hi);
    const float offB = carry + (hi == 0 ? T1p : 0.f);
    const float offA = carry + T1 + T1p + (hi == 0 ? T0p : 0.f);
    float Av[16];
#pragma unroll
    for (int r = 0; r < 16; ++r) {
        const float p = __builtin_amdgcn_exp2f(Sx[r] + (suf[r] + (r < 8 ? offA : offB)));
        if (MASK) { const int kk = 16 * (r >> 3) + 8 * hi + (r & 7); Av[r] = (kk < qlim) ? p : 0.f; } else Av[r] = p;
    }
    carry += (T0 + T1) + (T0p + T1p);
#pragma unroll
    for (int s = 0; s < 2; ++s) { u32x4 w; w.x = cvtpk(Av[8 * s], Av[8 * s + 1]); w.y = cvtpk(Av[8 * s + 2], Av[8 * s + 3]); w.z = cvtpk(Av[8 * s + 4], Av[8 * s + 5]); w.w = cvtpk(Av[8 * s + 6], Av[8 * s + 7]);
        pf[s] = __builtin_bit_cast(bf16x8, w); }
}
__device__ __forceinline__ void attn_phase(const bf16_t* Q, const bf16_t* Kb, const bf16_t* VT, bf16_t* O, LAS unsigned char* lds, int bx, int G, int tid) {
    const int lane = tid & 63, w = __builtin_amdgcn_readfirstlane(tid >> 6);
    const int ql = lane & 31, hi = lane >> 5;
    const int kperm = (ql & 0x13) | ((ql & 4) << 1) | ((ql & 8) >> 1);
    constexpr float THR = -110.0f * LOG2E;
    constexpr int NITEMS = NB * NH * (SEQ / 256);
    const int per = (NITEMS + G - 1) / G;
    const int it_end = (bx + 1) * per < NITEMS ? (bx + 1) * per : NITEMS;
    for (int it = bx * per; it < it_end; ++it) {
        const int bh = it >> 5, qblk = it & 31, b = bh >> 4, h = bh & 15;
        const int win0 = qblk * 256 - 256;
        __syncthreads();
        {
#pragma unroll
            for (int i = 0; i < 8; ++i) {
                const int slot = w * 64 + i * 8 + (lane >> 3), c = (lane & 7) ^ ((slot >> 1) & 7);
                int kpos = win0 + slot; kpos = kpos < 0 ? 0 : kpos;
                __builtin_amdgcn_global_load_lds((const unsigned*)(Kb + ((size_t)b * SEQ + kpos) * DM + h * 64 + c * 8), (LAS unsigned*)(lds + (w * 64 + i * 8) * 128), 16, 0, 0);
            }
#pragma unroll
            for (int i = 0; i < 8; ++i) {
                const int d = w * 8 + i, kc = lane ^ (d & 15);
                int kpos = win0 + 8 * kc; kpos = kpos < 0 ? 0 : kpos;
                __builtin_amdgcn_global_load_lds((const unsigned*)(VT + (size_t)(h * 64 + d) * M + (size_t)b * SEQ + kpos), (LAS unsigned*)(lds + 65536 + d * 1024), 16, 0, 0);
            }
        }
        const int qb = qblk * 8 + w;
        const size_t tok0 = (size_t)b * SEQ + (size_t)qb * 32;
        const bf16_t* qptr = Q + (tok0 + ql) * DM + h * 64 + 8 * hi;
        bf16x8 qf[4];
#pragma unroll
        for (int ks = 0; ks < 4; ++ks) qf[ks] = *(const bf16x8*)(qptr + 16 * ks);
        asm volatile("s_waitcnt vmcnt(0)" ::: "memory");
        __syncthreads();
        f32x16 o0, o1;
#pragma unroll
        for (int r = 0; r < 16; ++r) { o0[r] = 0.f; o1[r] = 0.f; }
        float carry = 0.f;
        const bf16_t* kbase = Kb + ((size_t)b * SEQ + kperm) * DM + h * 64 + 8 * hi;
        const bf16_t* vbase = VT + (size_t)(h * 64 + ql) * M + (size_t)b * SEQ + 8 * hi;
        for (int kt = qb; kt >= 0; --kt) {
            bf16x8 kf[4], vf[2][2];
            const int kr = kt * 32 - win0;
            if (kr >= 0) {
                const int ksl = kr + kperm, sw = (ksl >> 1) & 7;
                const LAS unsigned char* kl = lds + ksl * 128;
#pragma unroll
                for (int ks = 0; ks < 4; ++ks) kf[ks] = *(const LAS bf16x8*)(kl + (((2 * ks + hi) ^ sw) << 4));
                const int kc0 = (kr >> 3) + hi;
#pragma unroll
                for (int dh = 0; dh < 2; ++dh)
#pragma unroll
                    for (int s = 0; s < 2; ++s) vf[dh][s] = *(const LAS bf16x8*)(lds + 65536 + (dh * 32 + ql) * 1024 + (((kc0 + 2 * s) ^ (ql & 15)) << 4));
            } else {
                const bf16_t* kp = kbase + (size_t)kt * 32 * DM; const bf16_t* vp = vbase + kt * 32;
#pragma unroll
                for (int ks = 0; ks < 4; ++ks) kf[ks] = *(const bf16x8*)(kp + 16 * ks);
#pragma unroll
                for (int dh = 0; dh < 2; ++dh)
#pragma unroll
                    for (int s = 0; s < 2; ++s) vf[dh][s] = *(const bf16x8*)(vp + (size_t)dh * 32 * M + 16 * s);
            }
            f32x16 Sx;
#pragma unroll
            for (int r = 0; r < 16; ++r) Sx[r] = 0.f;
#pragma unroll
            for (int ks = 0; ks < 4; ++ks) Sx = __builtin_amdgcn_mfma_f32_32x32x16_bf16(kf[ks], qf[ks], Sx, 0, 0, 0);
            bf16x8 pf[2];
            if (kt == qb) sb_tile<true>(Sx, carry, hi, ql, pf); else sb_tile<false>(Sx, carry, hi, 0, pf);
#pragma unroll
            for (int s = 0; s < 2; ++s) { o0 = __builtin_amdgcn_mfma_f32_32x32x16_bf16(vf[0][s], pf[s], o0, 0, 0, 0); o1 = __builtin_amdgcn_mfma_f32_32x32x16_bf16(vf[1][s], pf[s], o1, 0, 0, 0); }
            if (__ballot(carry > THR) == 0ull) break;
        }
        bf16_t* op = O + (tok0 + ql) * DM + h * 64 + 4 * hi;
#pragma unroll
        for (int r4 = 0; r4 < 4; ++r4) {
            u32x2 w0; w0.x = cvtpk(o0[4 * r4], o0[4 * r4 + 1]); w0.y = cvtpk(o0[4 * r4 + 2], o0[4 * r4 + 3]);
            u32x2 w1; w1.x = cvtpk(o1[4 * r4], o1[4 * r4 + 1]); w1.y = cvtpk(o1[4 * r4 + 2], o1[4 * r4 + 3]);
            *(u32x2*)(op + 8 * r4) = w0; *(u32x2*)(op + 32 + 8 * r4) = w1;
        }
    }
    __syncthreads();
}

#define XB_TMO      128
#define XB_XCNT(j)  (256  + 64 * (j))
#define XB_XSUB(j)  (1280 + 64 * (j))
#define XB_XGEN(j)  (2304 + 64 * (j))
#define XB_TOP      3328
#define XB_TOPGEN   3392
#define XCD_BAR_WORDS 3456
#define XB_SPIN_CAP (1u << 18)

__device__ __forceinline__ unsigned xb_ld(unsigned* p)              { return __hip_atomic_load(p, __ATOMIC_RELAXED, __HIP_MEMORY_SCOPE_AGENT); }
__device__ __forceinline__ unsigned xb_add(unsigned* p, unsigned v) { return __hip_atomic_fetch_add(p, v, __ATOMIC_RELAXED, __HIP_MEMORY_SCOPE_AGENT); }
__device__ __forceinline__ unsigned xb_xcc_id() { return (unsigned)__builtin_amdgcn_s_getreg((3 << 11) | 20) & 0xFu; }
#define XB_SPIN(cond, bar) do { unsigned _sp = 0; while (cond) { __builtin_amdgcn_s_sleep(1); \
    if ((++_sp & 255u) == 0u) { if (xb_ld(&(bar)[XB_TMO])) break; if (_sp > XB_SPIN_CAP) { atomicAdd(&(bar)[XB_TMO], 1u); break; } } } } while (0)

struct XcdBarrier {
    unsigned* bar; unsigned x;
    volatile LAS unsigned* st;
};

__device__ __forceinline__ XcdBarrier xcd_barrier_post(unsigned* bar, volatile LAS unsigned* st) {
    XcdBarrier b; b.bar = bar; b.x = xb_xcc_id(); b.st = st;
    if (threadIdx.x == 0) (void)xb_add(&bar[XB_XCNT(b.x)], 1u);
    return b;
}
__device__ __forceinline__ void xcd_barrier_complete(unsigned* bar, unsigned x, unsigned& nloc, unsigned& nx) {
    const unsigned G = gridDim.x * gridDim.y * gridDim.z;
    unsigned sum, cnt, mine, sp = 0u;
    for (;;) {
        sum = 0u; cnt = 0u; mine = 0u;
#pragma unroll
        for (unsigned j = 0; j < 16; ++j) { const unsigned c = xb_ld(&bar[XB_XCNT(j)]); sum += c; cnt += (c > 0u) ? 1u : 0u; mine = (j == x) ? c : mine; }
        if (sum == G) break;
        __builtin_amdgcn_s_sleep(1);
        if ((++sp & 255u) == 0u) { if (xb_ld(&bar[XB_TMO])) break; if (sp > XB_SPIN_CAP) { atomicAdd(&bar[XB_TMO], 1u); break; } }
    }
    nloc = mine > 0u ? mine : 1u; nx = cnt > 0u ? cnt : 1u;
}

__device__ __forceinline__ void xcd_barrier(const XcdBarrier& b) {
    asm volatile("s_waitcnt vmcnt(0)" ::: "memory");
    __syncthreads();
    if (threadIdx.x == 0) {
        unsigned* bar = b.bar;
        __builtin_amdgcn_s_waitcnt(0);
        unsigned nloc = b.st[0], nx = b.st[1];
        if (nloc == 0u) { xcd_barrier_complete(bar, b.x, nloc, nx); b.st[0] = nloc; b.st[1] = nx; }
        const unsigned old = xb_add(&bar[XB_XSUB(b.x)], 1u);
        const unsigned gen = old / nloc;
        if (old + 1u == (gen + 1u) * nloc) {
            __builtin_amdgcn_fence(__ATOMIC_RELEASE, "agent");
            asm volatile("s_waitcnt vmcnt(0)" ::: "memory");
            const unsigned og = xb_add(&bar[XB_TOP], 1u);
            const unsigned tg = og / nx;
            if (og + 1u == (tg + 1u) * nx) xb_add(&bar[XB_TOPGEN], 1u);
            else XB_SPIN(xb_ld(&bar[XB_TOPGEN]) == tg, bar);
            __builtin_amdgcn_fence(__ATOMIC_ACQUIRE, "agent");
            xb_add(&bar[XB_XGEN(b.x)], 1u);
            asm volatile("s_waitcnt vmcnt(0)" ::: "memory");
        } else {
            XB_SPIN(xb_ld(&bar[XB_XGEN(b.x)]) == gen, bar);
            __builtin_amdgcn_fence(__ATOMIC_ACQUIRE, "agent");
            asm volatile("s_waitcnt vmcnt(0)" ::: "memory");
        }
    }
    __syncthreads();
}

constexpr int NSTEPS = 16;
__global__ void __launch_bounds__(512, 2) yoco_fwd(Args a_unused) {
    extern __shared__ __attribute__((aligned(16))) unsigned char lds_raw[];
    LAS unsigned char* lds = (LAS unsigned char*)lds_raw;
    const int st_lo = get_args()->st_lo, st_hi = get_args()->st_hi;
    volatile LAS unsigned* MISC = (volatile LAS unsigned*)(lds + RING_BYTES + 4096);
    if (threadIdx.x < 8) MISC[threadIdx.x] = 0u;
    __syncthreads();
    if (st_hi - st_lo > 1 && blockIdx.x == 0) {
        unsigned* bw = (unsigned*)(get_args()->ws + WS_BAR);
        for (int i = threadIdx.x; i < XCD_BAR_WORDS; i += 512) bw[i] = 0u;
    }
    for (int sti = st_lo; sti < st_hi; ++sti) {
        const int st = (sti <= MK_REP) ? sti : sti - 1;
        KArgs ap = get_args();
        unsigned char* ws = ap->ws;
        int tid = threadIdx.x; asm volatile("" : "+v"(tid));
        const int lane = tid & 63, wave = __builtin_amdgcn_readfirstlane(tid >> 6);
        const int G = gridDim.x, bx = blockIdx.x;
        const int gw = bx * 8 + wave, NGW = G * 8;
        if (st == 0) {
            prep_phase(ap, lds, gw, NGW, wave, lane);
        } else if (st == 3) {
            pool_in_phase((const bf16_t*)(ws + WS_HBB), (const float*)(ws + WS_SSB), (bf16_t*)(ws + WS_HBA), gw, NGW, lane);
        } else if (st == 12) {
            attn_phase((const bf16_t*)(ws + WS_HBB), (const bf16_t*)(ws + WS_K), (const bf16_t*)(ws + WS_VT), (bf16_t*)(ws + WS_HID), lds, bx, G, tid);
        } else if (st == 1 || st == 5 || st == 9 || st == 14) {
            const int f = (st == 1) ? 0 : (st == 5) ? 1 : (st == 9) ? 2 : 3;
            const bool useA = (st == 1 || st == 5);
            pg8::Gemm g{(const bf16_t*)(ws + (useA ? WS_HBA : WS_HBB)), (const bf16_t*)(ws + WS_WIN + f * WIN_BYTES), DM, DM, DM, 0};
            pg8::StaticOrder S; S.init(M / 256, NIN / 256, G, bx); S.mode = 1;
            pg8::EpiSwiGLU E{(bf16_t*)(ws + WS_HID), (const float*)(ws + (useA ? WS_SSA : WS_SSB))};
            pg8::gemm_phase(lds, g, S, E, tid);
        } else if (st == 7 || st == 11) {
            const bool isK = (st == 7);
            pg8::Gemm g{(const bf16_t*)(ws + (isK ? WS_HBB : WS_HBA)), (const bf16_t*)(ws + (isK ? WS_WK : WS_WQ)), DM, DM, DM, 0};
            pg8::StaticOrder S; S.init(M / 256, DM / 256, G, bx); S.mode = 3;
            pg8::EpiHeadNorm E{(bf16_t*)(ws + (isK ? WS_K : WS_HBB)), (const float*)(ws + (isK ? WS_SSB : WS_SSA)), ap->in[isK ? 12 : 15], isK ? 1.0f : 0.125f * LOG2E};
            pg8::gemm_phase(lds, g, S, E, tid);
        } else if (st == 8) {
            pg8::Gemm g{(const bf16_t*)(ws + WS_WV), (const bf16_t*)(ws + WS_HBB), DM, DM, DM, 0};
            pg8::StaticOrder S; S.init(DM / 256, M / 256, G, bx); S.mode = 4;
            pg8::EpiVT E{(bf16_t*)(ws + WS_VT), (const float*)(ws + WS_SSB)};
            pg8::gemm_phase(lds, g, S, E, tid);
        } else {
            const bool isP = (st == 4), isO = (st == 13), isF = !(isP || isO);
            const int f = (st == 2) ? 0 : (st == 6) ? 1 : (st == 10) ? 2 : 3;
            const bf16_t* gA = (const bf16_t*)(ws + ((isF || isO) ? WS_HID : WS_HBA));
            const bf16_t* gB = (const bf16_t*)(ws + (isP ? WS_WP : isO ? WS_WO : WS_WOUT + f * WOUT_BYTES));
            const int lda = isF ? FF : DM, ldb = isP ? 256 : isO ? DM : FF;
            pg8::Gemm g{gA, gB, lda, ldb, ldb, isP ? 512 : 0};
            const bool toA = (st == 4 || st == 10);
            pg8::StaticOrder S; S.init(M / 256, DM / 256, G, bx); S.mode = 3;
            const bf16_t* resp = (const bf16_t*)(ws + ((toA || st == 15) ? WS_HBB : WS_HBA));
            if (st == 15) { pg8::EpiRes<true> E{resp, nullptr, ap->out, nullptr}; pg8::gemm_phase(lds, g, S, E, tid); }
            else { pg8::EpiRes<false> E{resp, (bf16_t*)(ws + (toA ? WS_HBA : WS_HBB)), nullptr, (float*)(ws + (toA ? WS_SSA : WS_SSB))}; pg8::gemm_phase(lds, g, S, E, tid); }
        }
        if (sti + 1 < st_hi && st != 7 && st != 8) {
            if (sti == st_lo) { cg::this_grid().sync(); (void)xcd_barrier_post((unsigned*)(ws + WS_BAR), MISC); }
            else { XcdBarrier xb; xb.bar = (unsigned*)(ws + WS_BAR); xb.x = xb_xcc_id(); xb.st = MISC; xcd_barrier(xb); }
        }
    }
}

extern "C" void kernel_launch(void* const* d_in, const int* in_sizes, int n_in, void* d_out, int out_size, void* d_ws, size_t ws_size, hipStream_t stream) {
    static int grid = 0;
    if (grid == 0) {
        if (n_in != 17 || out_size != M * DM || ws_size < WS_END) { fprintf(stderr, "kernel_launch: unexpected shapes (n_in %d out %d ws %zu)\n", n_in, out_size, ws_size); grid = -1; return; }
        int dev = 0, cus = 0, per_cu = 0;
        hipGetDevice(&dev);
        hipDeviceGetAttribute(&cus, hipDeviceAttributeMultiprocessorCount, dev);
        hipFuncSetAttribute((const void*)yoco_fwd, hipFuncAttributeMaxDynamicSharedMemorySize, LDS_BYTES);
        hipOccupancyMaxActiveBlocksPerMultiprocessor(&per_cu, (const void*)yoco_fwd, 512, LDS_BYTES);
        (void)hipGetLastError();
        if (per_cu < 1) per_cu = 1;
        grid = cus * per_cu;
    }
    if (grid < 0) return;
    Args a{};
    for (int i = 0; i < 17; ++i) a.in[i] = (const float*)d_in[i];
    a.out = (float*)d_out; a.ws = (unsigned char*)d_ws;
#if MK_SINGLE
    a.st_lo = 0; a.st_hi = NSTEPS + (MK_REP < NSTEPS ? 1 : 0);
    void* args[] = {&a};
    hipError_t e = hipLaunchCooperativeKernel((const void*)yoco_fwd, dim3(grid), dim3(512), args, LDS_BYTES, stream);
    if (e != hipSuccess) fprintf(stderr, "cooperative launch failed: %s (grid %d)\n", hipGetErrorString(e), grid);
#else
    for (int st = 0; st < NSTEPS; ++st) {
        a.st_lo = st; a.st_hi = st + 1;
        hipLaunchKernelGGL(yoco_fwd, dim3(grid), dim3(512), LDS_BYTES, stream, a);
    }
#endif
}
```

```cpp
#include <hip/hip_runtime.h>
#include <hip/hip_cooperative_groups.h>
#include <cstdio>
#include <cstdint>
namespace cg = cooperative_groups;

#ifndef MK_SINGLE
#define MK_SINGLE 1
#endif

#ifndef MK_REP
#define MK_REP 99
#endif
#define LAS __attribute__((address_space(3)))
typedef unsigned short bf16_t;
typedef short bf16x8 __attribute__((ext_vector_type(8)));
typedef float f32x4 __attribute__((ext_vector_type(4)));
typedef float f32x16 __attribute__((ext_vector_type(16)));
typedef unsigned u32x4 __attribute__((ext_vector_type(4)));
typedef unsigned u32x2 __attribute__((ext_vector_type(2)));
typedef float f32x2_t __attribute__((ext_vector_type(2)));
typedef __bf16 bf16x2_t __attribute__((ext_vector_type(2)));

constexpr int DM = 1024, NB = 8, SEQ = 8192, M = NB * SEQ, NH = 16, HD = 64, FF = 2816, NIN = 2 * FF;
constexpr float EPS = 1e-6f;
constexpr float LOG2E = 1.4426950408889634f, LN2 = 0.6931471805599453f;

constexpr size_t MiB = 1u << 20;
constexpr size_t WS_SSA = 0, WS_SSB = 1 * MiB;
constexpr size_t WS_BAR = 2 * MiB;
constexpr size_t WS_WIN = 4 * MiB, WIN_BYTES = (size_t)NIN * DM * 2;
constexpr size_t WS_WOUT = 48 * MiB, WOUT_BYTES = (size_t)DM * FF * 2;
constexpr size_t WS_WK = 70 * MiB, WS_WV = 72 * MiB, WS_WQ = 74 * MiB, WS_WO = 76 * MiB, WS_WP = 78 * MiB;
constexpr size_t WS_HBA = 80 * MiB, WS_HBB = 208 * MiB;
constexpr size_t WS_HID = 336 * MiB;
constexpr size_t WS_K = 688 * MiB, WS_VT = 816 * MiB, WS_END = 944 * MiB;
static_assert(WS_WIN + 4 * WIN_BYTES <= WS_WOUT && WS_WOUT + 4 * WOUT_BYTES <= WS_WK, "ws map");
static_assert(WS_HID + (size_t)M * FF * 2 <= WS_K, "ws map");

constexpr int RING_BYTES = 131072, SCR_OFF = RING_BYTES, SS_OFF = RING_BYTES + 8192, LDS_BYTES = RING_BYTES + 16384;

__device__ __forceinline__ unsigned cvtpk(float lo, float hi) { f32x2_t v = {lo, hi}; bf16x2_t b = __builtin_convertvector(v, bf16x2_t); return __builtin_bit_cast(unsigned, b); }
__device__ __forceinline__ float rstd_from(const f32x4 s) { float a = s[0] + s[1], b = s[2] + s[3]; asm volatile("" : "+v"(a), "+v"(b));
    return __builtin_amdgcn_rsqf((a + b) * (1.0f / DM) + EPS); }

__device__ __forceinline__ f32x4 zero4() {
    typedef unsigned long long u64x2 __attribute__((ext_vector_type(2)));
    unsigned long long a, b; asm volatile("v_mov_b64 %0, 0\n\tv_mov_b64 %1, 0" : "=v"(a), "=v"(b));
    u64x2 v = {a, b}; return __builtin_bit_cast(f32x4, v);
}
namespace pg8 {
constexpr int BM = 256, BK = 64, HALF = 128, HTB = HALF * BK * 2, NXCD = 8, WGM = 8;
__device__ __forceinline__ int lds_byte(int r, int c) { const int st = (r >> 4) * 2 + (c >> 5), rr = r & 15, cc = c & 31, ob = rr * 64 + cc * 2; return st * 1024 + (ob ^ (((ob >> 9) & 1) << 5)); }
__device__ __forceinline__ void stage_rc(int b, int& R, int& C) { const int st = b / 1024, sb = b % 1024, swz = sb ^ (((sb >> 9) & 1) << 5); R = (st >> 1) * 16 + swz / 64; C = (st & 1) * 32 + (swz % 64) / 2; }
__device__ __forceinline__ int perm32(int rho) { const int n = rho >> 4, i = rho & 15; return 8 * (i >> 2) + 4 * n + (i & 3); }

struct Unit { int pm, pn; };
struct Gemm { const bf16_t* A; const bf16_t* Bt; int lda, ldb, K, a_pn_bytes; };

struct StaticOrder {
    int nM, nN, nwg, G, c, mode = 0;
    __device__ __forceinline__ void init(int nM_, int nN_, int G_, int c_) { nM = nM_; nN = nN_; nwg = nM * nN; G = G_; c = c_; }
    __device__ __forceinline__ bool next(int i, Unit& u) const {
        const long L = (long)i * G + c; if (L >= nwg) return false;
        int wgid = (int)L;
        if (mode == 3) {
            const int w2 = (wgid & 7) * 128 + (wgid >> 3), r32 = w2 & 31; u.pm = (w2 >> 5) * 8 + (r32 & 7); u.pn = r32 >> 3; return true;
        }
        if (mode == 4) {
            const int w2 = (wgid & 7) * 128 + (wgid >> 3); u.pm = w2 & 3; u.pn = w2 >> 2; return true;
        }
        if (mode == 1) {
            const int xcd = wgid & 7, p = wgid >> 3; int pml, pn;
            if (p < 640) { const int j = p >> 7, rem = p & 127, b = rem >> 5, k = rem & 31; pml = 8 * b + (k & 7); pn = 4 * j + (k >> 3); }
            else { const int pp = p - 640, b = pp >> 4, k = pp & 15; pml = 8 * b + (k & 7); pn = 20 + (k >> 3); }
            u.pm = 32 * xcd + pml; u.pn = pn; return true;
        } { const int q = nwg / NXCD, r = nwg % NXCD, xcd = wgid % NXCD, off = wgid / NXCD; wgid = (xcd < r ? xcd * (q + 1) : r * (q + 1) + (xcd - r) * q) + off; }
        const int nig = WGM * nN, gid = wgid / nig, fm = gid * WGM, gsz = (nM - fm) < WGM ? (nM - fm) : WGM;
        u.pm = fm + ((wgid % nig) % gsz); u.pn = (wgid % nig) / gsz; return true;
    }
};


struct EpiSwiGLU {
    static constexpr int SS_STAGE = 1;
    bf16_t* H; const float* ss4;
    __device__ __forceinline__ void operator()(const f32x4 (&acc)[2][2][4][2], const Unit& u, int wr, int wc, int fr, int fq, int tid, LAS float* scr, int sbuf) const {
        const int row0 = u.pm * BM + wr * 64 + fr, col0 = u.pn * 128 + wc * 32 + 8 * fq;
        f32x4 sv[2][4];
#pragma unroll
        for (int ai = 0; ai < 2; ++ai)
#pragma unroll
            for (int m = 0; m < 4; ++m) sv[ai][m] = *(const LAS f32x4*)((const LAS unsigned char*)scr + 8192 + sbuf * 4096 + (ai * HALF + wr * 64 + m * 16 + fr) * 16);
#pragma unroll
        for (int ai = 0; ai < 2; ++ai)
#pragma unroll
            for (int m = 0; m < 4; ++m) {
                const int row = row0 + ai * HALF + m * 16;
                const float rs = rstd_from(sv[ai][m]), rs2 = rs * (-LOG2E), irsq = __builtin_amdgcn_rcpf(rs * rs);
                float o[8];
#pragma unroll
                for (int n = 0; n < 2; ++n)
#pragma unroll
                    for (int p = 0; p < 2; ++p) {
                        const f32x2_t ag = {acc[ai][0][m][n][2 * p], acc[ai][0][m][n][2 * p + 1]}, au = {acc[ai][1][m][n][2 * p], acc[ai][1][m][n][2 * p + 1]};
                        const f32x2_t t = ag * rs2;
                        f32x2_t d; d.x = __builtin_amdgcn_exp2f(t.x); d.y = __builtin_amdgcn_exp2f(t.y); d = d * irsq + irsq;
                        f32x2_t r; r.x = __builtin_amdgcn_rcpf(d.x); r.y = __builtin_amdgcn_rcpf(d.y);
                        const f32x2_t res = (ag * au) * r;
                        o[n * 4 + 2 * p] = res.x; o[n * 4 + 2 * p + 1] = res.y;
                    }
                u32x4 w; w.x = cvtpk(o[0], o[1]); w.y = cvtpk(o[2], o[3]); w.z = cvtpk(o[4], o[5]); w.w = cvtpk(o[6], o[7]);
                *(u32x4*)(H + (size_t)row * FF + col0) = w;
            }
    }
};

__device__ __forceinline__ void unpack8v(const u32x4 p, f32x4& a, f32x4& b) {
    a[0] = __builtin_bit_cast(float, p[0] << 16); a[1] = __builtin_bit_cast(float, p[0] & 0xffff0000u); a[2] = __builtin_bit_cast(float, p[1] << 16); a[3] = __builtin_bit_cast(float, p[1] & 0xffff0000u);
    b[0] = __builtin_bit_cast(float, p[2] << 16); b[1] = __builtin_bit_cast(float, p[2] & 0xffff0000u); b[2] = __builtin_bit_cast(float, p[3] << 16); b[3] = __builtin_bit_cast(float, p[3] & 0xffff0000u);
}
template <bool FIN> struct EpiRes {
    static constexpr int SS_STAGE = 0;
    const bf16_t* res; bf16_t* outb; float* outf; float* ss4;
    __device__ __forceinline__ void operator()(const f32x4 (&acc)[2][2][4][2], const Unit& u, int wr, int wc, int fr, int fq, int tid, LAS float* scr, int sbuf) const {
        const int row0 = u.pm * BM + wr * 64 + fr, col0 = u.pn * BM + wc * 32 + 8 * fq;
        u32x4 rv[2][4][2];
#pragma unroll
        for (int ai = 0; ai < 2; ++ai)
#pragma unroll
            for (int m = 0; m < 4; ++m)
#pragma unroll
                for (int bj = 0; bj < 2; ++bj) rv[ai][m][bj] = *(const u32x4*)(res + (size_t)(row0 + ai * HALF + m * 16) * DM + col0 + bj * HALF);
        float s8[8];
#pragma unroll
        for (int ai = 0; ai < 2; ++ai) {
#pragma unroll
            for (int m = 0; m < 4; ++m) {
                const int row = row0 + ai * HALF + m * 16; f32x2_t sq = {0.f, 0.f};
#pragma unroll
                for (int bj = 0; bj < 2; ++bj) {
                    const size_t off = (size_t)row * DM + col0 + bj * HALF;
                    const u32x4 p = rv[ai][m][bj]; f32x2_t v[4];
#pragma unroll
                    for (int q = 0; q < 4; ++q) {
                        const f32x2_t r = {__builtin_bit_cast(float, p[q] << 16), __builtin_bit_cast(float, p[q] & 0xffff0000u)};
                        const f32x2_t a = {acc[ai][bj][m][q >> 1][2 * (q & 1)], acc[ai][bj][m][q >> 1][2 * (q & 1) + 1]};
                        v[q] = r + a; if (!FIN) sq = v[q] * v[q] + sq;
                    }
                    if (FIN) { *(f32x4*)(outf + off) = (f32x4){v[0].x, v[0].y, v[1].x, v[1].y}; *(f32x4*)(outf + off + 4) = (f32x4){v[2].x, v[2].y, v[3].x, v[3].y}; }
                    else { u32x4 w; w.x = cvtpk(v[0].x, v[0].y); w.y = cvtpk(v[1].x, v[1].y); w.z = cvtpk(v[2].x, v[2].y); w.w = cvtpk(v[3].x, v[3].y); *(u32x4*)(outb + off) = w; }
                }
                s8[ai * 4 + m] = sq.x + sq.y;
            }
        }
        if (!FIN) {
            float t8[8];
#pragma unroll
            for (int i = 0; i < 8; ++i) t8[i] = __shfl_xor(s8[i], 16);
#pragma unroll
            for (int i = 0; i < 8; ++i) s8[i] += t8[i];
#pragma unroll
            for (int i = 0; i < 8; ++i) t8[i] = __shfl_xor(s8[i], 32);
#pragma unroll
            for (int i = 0; i < 8; ++i) if (fq == 0) scr[((i >> 2) * HALF + wr * 64 + (i & 3) * 16 + fr) * 4 + wc] = s8[i] + t8[i];
            asm volatile("s_waitcnt lgkmcnt(0)" ::: "memory"); __builtin_amdgcn_s_barrier(); asm volatile("" ::: "memory");
            if (tid < 256) { const f32x4 p = *(const LAS f32x4*)(scr + tid * 4); ss4[(size_t)(u.pm * BM + tid) * 4 + u.pn] = (p[0] + p[1]) + (p[2] + p[3]); }
        }
    }
};

struct EpiHeadNorm {
    static constexpr int SS_STAGE = 1;
    bf16_t* O; const float* ss4; const float* gain; float oscale;
    __device__ __forceinline__ void operator()(const f32x4 (&acc)[2][2][4][2], const Unit& u, int wr, int wc, int fr, int fq, int tid, LAS float* scr, int sbuf) const {
        const int row0 = u.pm * BM + wr * 64 + fr, colh = (u.pn * 4 + wc) * 64 + 8 * fq;
        f32x4 gv[2][2];
#pragma unroll
        for (int bj = 0; bj < 2; ++bj)
#pragma unroll
            for (int n = 0; n < 2; ++n) gv[bj][n] = *(const f32x4*)(gain + 32 * bj + 8 * fq + 4 * n);
        float s8[8], rs8[8];
#pragma unroll
        for (int ai = 0; ai < 2; ++ai)
#pragma unroll
            for (int m = 0; m < 4; ++m) {
                rs8[ai * 4 + m] = rstd_from(*(const LAS f32x4*)((const LAS unsigned char*)scr + 8192 + sbuf * 4096 + (ai * HALF + wr * 64 + m * 16 + fr) * 16));
                f32x4 q = acc[ai][0][m][0] * acc[ai][0][m][0]; q = acc[ai][0][m][1] * acc[ai][0][m][1] + q; q = acc[ai][1][m][0] * acc[ai][1][m][0] + q; q = acc[ai][1][m][1] * acc[ai][1][m][1] + q;
                s8[ai * 4 + m] = (q[0] + q[1]) + (q[2] + q[3]);
            }
        float t8[8];
#pragma unroll
        for (int i = 0; i < 8; ++i) t8[i] = __shfl_xor(s8[i], 16);
#pragma unroll
        for (int i = 0; i < 8; ++i) s8[i] += t8[i];
#pragma unroll
        for (int i = 0; i < 8; ++i) t8[i] = __shfl_xor(s8[i], 32);
#pragma unroll
        for (int ai = 0; ai < 2; ++ai)
#pragma unroll
            for (int m = 0; m < 4; ++m) {
                const int i = ai * 4 + m, row = row0 + ai * HALF + m * 16;
                const float rs = rs8[i], hr = rs * __builtin_amdgcn_rsqf((s8[i] + t8[i]) * (rs * rs) * (1.0f / HD) + EPS) * oscale;
#pragma unroll
                for (int bj = 0; bj < 2; ++bj) {
                    const f32x4 a = acc[ai][bj][m][0] * gv[bj][0] * hr, b = acc[ai][bj][m][1] * gv[bj][1] * hr;
                    u32x4 w; w.x = cvtpk(a[0], a[1]); w.y = cvtpk(a[2], a[3]); w.z = cvtpk(b[0], b[1]); w.w = cvtpk(b[2], b[3]);
                    *(u32x4*)(O + (size_t)row * DM + colh + 32 * bj) = w;
                }
            }
    }
};

struct EpiVT {
    static constexpr int SS_STAGE = 2;
    bf16_t* VT; const float* ss4;
    __device__ __forceinline__ void operator()(const f32x4 (&acc)[2][2][4][2], const Unit& u, int wr, int wc, int fr, int fq, int tid, LAS float* scr, int sbuf) const {
        const int row0 = u.pm * BM + wr * 64 + fr, col0 = u.pn * BM + wc * 32 + 8 * fq;
        float rs[2][8];
#pragma unroll
        for (int bj = 0; bj < 2; ++bj)
#pragma unroll
            for (int j = 0; j < 8; ++j) rs[bj][j] = rstd_from(*(const LAS f32x4*)((const LAS unsigned char*)scr + 8192 + sbuf * 4096 + (bj * HALF + wc * 32 + 8 * fq + j) * 16));
#pragma unroll
        for (int ai = 0; ai < 2; ++ai)
#pragma unroll
            for (int m = 0; m < 4; ++m) {
                const int row = row0 + ai * HALF + m * 16;
#pragma unroll
                for (int bj = 0; bj < 2; ++bj) {
                    const f32x4 a = acc[ai][bj][m][0], b = acc[ai][bj][m][1];
                    u32x4 w; w.x = cvtpk(a[0] * rs[bj][0], a[1] * rs[bj][1]); w.y = cvtpk(a[2] * rs[bj][2], a[3] * rs[bj][3]);
                    w.z = cvtpk(b[0] * rs[bj][4], b[1] * rs[bj][5]); w.w = cvtpk(b[2] * rs[bj][6], b[3] * rs[bj][7]);
                    *(u32x4*)(VT + (size_t)row * M + col0 + bj * HALF) = w;
                }
            }
    }
};

template <class Epi>
__device__ __forceinline__ void gemm_phase(LAS unsigned char* lds, const Gemm g, const StaticOrder& S, const Epi& E, const int tid) {
    const int wid = __builtin_amdgcn_readfirstlane(tid >> 6), lane = tid & 63, wr = wid >> 2, wc = wid & 3, fr = lane & 15, fq = lane >> 4;
    const int K = g.K, nt = K / BK;
    unsigned voffA[2], voffB[2];
#pragma unroll
    for (int i = 0; i < 2; ++i) { int R, C; stage_rc(tid * 16 + i * 8192, R, C); const int Rb = (R & ~31) + perm32(R & 31);
        voffA[i] = (unsigned)(R * g.lda + C) * 2u; voffB[i] = (unsigned)(Rb * g.ldb + C) * 2u; }
    const size_t kstep = (size_t)(BK * 2);
    const size_t hstepA = (size_t)HALF * g.lda * 2, hstepB = (size_t)HALF * g.ldb * 2;
    const size_t tstepA = 2 * hstepA, tstepB = 2 * hstepB;
    const unsigned ldsw = (unsigned)wid * 1024u;
    const int aoff = lds_byte(wr * 64 + fr, fq * 8), boff = lds_byte(wc * 32 + fr, fq * 8);
#define PG8_SA(b, h) (((b) * 2 + (h)) * HTB)
#define PG8_SB(b, h) ((4 + (b) * 2 + (h)) * HTB)
#define PG8_STAGE(bufoff, gbase, voff) do { _Pragma("unroll") for (int _i = 0; _i < 2; ++_i) \
        __builtin_amdgcn_global_load_lds((const unsigned*)((const char*)(gbase) + (voff)[_i]), (LAS unsigned*)(lds + (bufoff) + ldsw + _i * 8192), 16, 0, 0); } while (0)
#define PG8_LDA(dst, b, h) do { _Pragma("unroll") for (int m = 0; m < 4; ++m) _Pragma("unroll") for (int k = 0; k < 2; ++k) dst[m][k] = *(const LAS bf16x8*)(lds + PG8_SA(b, h) + aoff + m * 2048 + k * 1024); } while (0)
#define PG8_LDB(dst, b, h) do { _Pragma("unroll") for (int n = 0; n < 2; ++n) _Pragma("unroll") for (int k = 0; k < 2; ++k) dst[n][k] = *(const LAS bf16x8*)(lds + PG8_SB(b, h) + boff + n * 2048 + k * 1024); } while (0)
#define PG8_MMA(ai, bj, At, Bt) do { __builtin_amdgcn_s_setprio(1); _Pragma("unroll") for (int m = 0; m < 4; ++m) _Pragma("unroll") for (int n = 0; n < 2; ++n) _Pragma("unroll") for (int k = 0; k < 2; ++k) \
        acc[ai][bj][m][n] = __builtin_amdgcn_mfma_f32_16x16x32_bf16(Bt[n][k], At[m][k], acc[ai][bj][m][n], 0, 0, 0); __builtin_amdgcn_s_setprio(0); } while (0)
#define PG8_WAIT_V(n) asm volatile("s_waitcnt vmcnt(" #n ")" ::: "memory")
#define PG8_WAIT_L(n) asm volatile("s_waitcnt lgkmcnt(" #n ")" ::: "memory")
#define PG8_BAR __builtin_amdgcn_s_barrier()
#define PG8_SCHED __builtin_amdgcn_sched_barrier(0)
    Unit cur, nxt; int ui = 0;
    if (!S.next(0, cur)) return;
#define PG8_SS_PREFETCH(U, BUF) do { if (Epi::SS_STAGE != 0 && wid < 4) { const char* sb_ = (const char*)E.ss4 + (size_t)((Epi::SS_STAGE == 2 ? (U).pn : (U).pm) * BM + wid * 64) * 16; \
        __builtin_amdgcn_global_load_lds((const unsigned*)(sb_ + (unsigned)lane * 16u), (LAS unsigned*)(lds + SS_OFF + (BUF) * 4096 + wid * 1024), 16, 0, 0); } } while (0)
    PG8_SS_PREFETCH(cur, 0);
    f32x4 acc[2][2][4][2];
#pragma unroll
    for (int a = 0; a < 2; ++a)
#pragma unroll
        for (int b = 0; b < 2; ++b)
#pragma unroll
            for (int m = 0; m < 4; ++m)
#pragma unroll
                for (int n = 0; n < 2; ++n) acc[a][b][m][n] = zero4();
    bf16x8 At[4][2], B0[2][2], B1[2][2];
    const char* cA = (const char*)g.A + (size_t)cur.pm * tstepA + (size_t)cur.pn * g.a_pn_bytes; const char* cB = (const char*)g.Bt + (size_t)cur.pn * tstepB;
    PG8_STAGE(PG8_SB(0, 0), cB, voffB); PG8_STAGE(PG8_SB(0, 1), cB + hstepB, voffB); PG8_STAGE(PG8_SA(0, 0), cA, voffA); PG8_STAGE(PG8_SA(0, 1), cA + hstepA, voffA);
    if (wr == 1) PG8_BAR;
    PG8_WAIT_V(2); PG8_BAR;
    PG8_STAGE(PG8_SB(1, 0), cB + kstep, voffB); PG8_STAGE(PG8_SA(1, 0), cA + kstep, voffA); PG8_STAGE(PG8_SB(1, 1), cB + hstepB + kstep, voffB);
    PG8_WAIT_V(6); PG8_BAR;
    for (;;) {
        const bool has_next = S.next(ui + 1, nxt);
        const char* nA = has_next ? (const char*)g.A + (size_t)nxt.pm * tstepA + (size_t)nxt.pn * g.a_pn_bytes : cA; const char* nB = has_next ? (const char*)g.Bt + (size_t)nxt.pn * tstepB : cB;
        for (int t = 0; t < nt; t += 2) {
            const bool last = (t == nt - 2);
            const char* a1 = cA + (size_t)(t + 1) * kstep;
            const char* a2 = last ? nA : cA + (size_t)(t + 2) * kstep; const char* b2 = last ? nB : cB + (size_t)(t + 2) * kstep;
            const char* a3 = a2 + kstep; const char* b3 = b2 + kstep;
            PG8_LDB(B0, 0, 0); PG8_LDB(B1, 0, 1); PG8_SCHED; PG8_LDA(At, 0, 0); PG8_STAGE(PG8_SA(1, 1), a1 + hstepA, voffA);
            PG8_WAIT_V(8); PG8_WAIT_L(0); PG8_BAR; PG8_MMA(0, 0, At, B0); PG8_MMA(0, 1, At, B1); PG8_BAR; PG8_SCHED;
            PG8_LDA(At, 0, 1); PG8_STAGE(PG8_SB(0, 0), b2, voffB); PG8_STAGE(PG8_SB(0, 1), b2 + hstepB, voffB); PG8_STAGE(PG8_SA(0, 0), a2, voffA);
            PG8_WAIT_V(8); PG8_WAIT_L(0); PG8_BAR; PG8_MMA(1, 0, At, B0); PG8_MMA(1, 1, At, B1); PG8_BAR; PG8_SCHED;
            PG8_LDB(B0, 1, 0); PG8_LDB(B1, 1, 1); PG8_SCHED; PG8_LDA(At, 1, 0); PG8_STAGE(PG8_SA(0, 1), a2 + hstepA, voffA);
            PG8_WAIT_V(8); PG8_WAIT_L(0); PG8_BAR; PG8_MMA(0, 0, At, B0); PG8_MMA(0, 1, At, B1); PG8_BAR; PG8_SCHED;
            PG8_LDA(At, 1, 1); PG8_STAGE(PG8_SB(1, 0), b3, voffB); PG8_STAGE(PG8_SB(1, 1), b3 + hstepB, voffB); PG8_STAGE(PG8_SA(1, 0), a3, voffA);
            PG8_WAIT_V(8); PG8_WAIT_L(0); PG8_BAR; PG8_MMA(1, 0, At, B0); PG8_MMA(1, 1, At, B1); PG8_BAR; PG8_SCHED;
        }
        if (wr == 0) PG8_BAR;
        E(acc, cur, wr, wc, fr, fq, tid, (LAS float*)(lds + 131072), ui & 1);
        if (!has_next) break;
        PG8_SS_PREFETCH(nxt, (ui + 1) & 1);
#pragma unroll
        for (int a = 0; a < 2; ++a)
#pragma unroll
            for (int b = 0; b < 2; ++b)
#pragma unroll
                for (int m = 0; m < 4; ++m)
#pragma unroll
                    for (int n = 0; n < 2; ++n) acc[a][b][m][n] = zero4();
        cur = nxt; cA = nA; cB = nB; ++ui;
        if (wr == 1) PG8_BAR;
    }
    PG8_WAIT_V(0);
    PG8_BAR;
#undef PG8_SA
#undef PG8_SB
#undef PG8_STAGE
#undef PG8_LDA
#undef PG8_LDB
#undef PG8_MMA
#undef PG8_WAIT_V
#undef PG8_WAIT_L
#undef PG8_BAR
#undef PG8_SCHED
#undef PG8_SS_PREFETCH
}
}

__device__ __forceinline__ void tr_item(const float* W, int ldn, int k0, int n0, const float* gk, const float* cs, bf16_t* WT, int ldk, int drow0, LAS float* scr, int lane, float mul = 1.f) {
    const int n = lane & 31, kh = lane >> 5;
    const float csn = (cs ? cs[n0 + n] : 1.f) * mul;
    float wv[32];
#pragma unroll
    for (int i = 0; i < 32; ++i) wv[i] = __builtin_nontemporal_load(W + (size_t)(k0 + 2 * i + kh) * ldn + n0 + n);
#pragma unroll
    for (int i = 0; i < 32; ++i) { const int kk = 2 * i + kh; const float gg = gk ? gk[k0 + kk] : 1.f; scr[kk * 33 + n] = wv[i] * gg * csn; }
    asm volatile("s_waitcnt lgkmcnt(0)" ::: "memory");
    const int c = lane & 7;
#pragma unroll
    for (int j = 0; j < 4; ++j) { const int nn = (lane >> 3) + 8 * j; const LAS float* s = scr + (8 * c) * 33 + nn;
        u32x4 o; o.x = cvtpk(s[0 * 33], s[1 * 33]); o.y = cvtpk(s[2 * 33], s[3 * 33]); o.z = cvtpk(s[4 * 33], s[5 * 33]); o.w = cvtpk(s[6 * 33], s[7 * 33]);
        *(u32x4*)(WT + (size_t)(drow0 + nn) * ldk + k0 + 8 * c) = o; }
    asm volatile("s_waitcnt lgkmcnt(0)" ::: "memory");
}

struct Args { const float* in[17]; float* out; unsigned char* ws; int st_lo, st_hi; };

typedef const __attribute__((address_space(4))) Args* KArgs;
__device__ __forceinline__ KArgs get_args() { const __attribute__((address_space(4))) void* p = (const __attribute__((address_space(4))) void*)__builtin_amdgcn_kernarg_segment_ptr(); asm volatile("" : "+s"(p)); return (KArgs)p; }
__device__ __forceinline__ void prep_phase(KArgs ap, LAS unsigned char* lds, int gw, int NGW, int wave, int lane) {
    LAS float* scr = (LAS float*)(lds + wave * 16384);
    unsigned char* ws = ap->ws;
    constexpr int I_IN = (DM / 64) * (NIN / 32);
    constexpr int I_OUT = (FF / 64) * (DM / 32);
    constexpr int I_SQ = (DM / 64) * (DM / 32);
    constexpr int I_P = 4 * (256 / 64) * (256 / 32);
    constexpr int NITEMS = 4 * I_IN + 4 * I_OUT + 4 * I_SQ + I_P;
    for (int it = gw; it < NITEMS; it += NGW) {
        int r = it;
        if (r < 4 * I_IN) {
            const int f = r / I_IN; r -= f * I_IN; const int l = f >> 1;
            const float* W = ap->in[(f & 1) ? 5 : 2] + (size_t)l * DM * NIN; const float* gk = ap->in[(f & 1) ? 4 : 1] + l * DM;
            const int nblk = NIN / 32, kb = r / nblk, db = r % nblk, R = 32 * db, pn = R >> 8, bj = (R >> 7) & 1, j = R & 127;
            tr_item(W, NIN, 64 * kb, bj * FF + 128 * pn + j, gk, nullptr, (bf16_t*)(ws + WS_WIN + f * WIN_BYTES), DM, R, scr, lane);
            continue;
        }
        r -= 4 * I_IN;
        if (r < 4 * I_OUT) {
            const int f = r / I_OUT; r -= f * I_OUT; const int l = f >> 1;
            const float* W = ap->in[(f & 1) ? 6 : 3] + (size_t)l * FF * DM;
            const int nblk = DM / 32, kb = r / nblk, db = r % nblk;
            tr_item(W, DM, 64 * kb, 32 * db, nullptr, nullptr, (bf16_t*)(ws + WS_WOUT + f * WOUT_BYTES), FF, 32 * db, scr, lane, 0.5f);
            continue;
        }
        r -= 4 * I_OUT;
        if (r < 4 * I_SQ) {
            const int q = r / I_SQ; r -= q * I_SQ; const int kb = r / 32, db = r % 32, R = 32 * db;
            const int srcp = (R & ~255) + 64 * ((R >> 5) & 3) + 32 * ((R >> 7) & 1);
            if (q == 0)      tr_item(ap->in[11], 2 * DM, 64 * kb, srcp, ap->in[10], nullptr, (bf16_t*)(ws + WS_WK), DM, R, scr, lane);
            else if (q == 1) tr_item(ap->in[11], 2 * DM, 64 * kb, DM + R, ap->in[10], nullptr, (bf16_t*)(ws + WS_WV), DM, R, scr, lane);
            else if (q == 2) tr_item(ap->in[14], DM, 64 * kb, srcp, ap->in[13], nullptr, (bf16_t*)(ws + WS_WQ), DM, R, scr, lane);
            else             tr_item(ap->in[16], DM, 64 * kb, R, nullptr, nullptr, (bf16_t*)(ws + WS_WO), DM, R, scr, lane);
            continue;
        }
        r -= 4 * I_SQ;
        { const int gI = r / 32; r -= gI * 32; const int kb = r / 8, db = r % 8;
          tr_item(ap->in[8] + (size_t)gI * 65536, 256, 64 * kb, 32 * db, ap->in[7] + gI * 256, ap->in[9] + gI * 256, (bf16_t*)(ws + WS_WP) + (size_t)gI * 65536, 256, 32 * db, scr, lane); }
    }
    const float* x = ap->in[0]; bf16_t* xb = (bf16_t*)(ws + WS_HBA); float* ss = (float*)(ws + WS_SSA);
    for (int m0 = gw * 4; m0 < M; m0 += NGW * 4) {
        f32x4 v[4][4]; float sq[4];
#pragma unroll
        for (int rr = 0; rr < 4; ++rr) { const f32x4* xr = (const f32x4*)(x + (size_t)(m0 + rr) * DM) + lane;
#pragma unroll
            for (int j = 0; j < 4; ++j) v[rr][j] = __builtin_nontemporal_load(xr + 64 * j); }
#pragma unroll
        for (int rr = 0; rr < 4; ++rr) { float s = 0.f;
#pragma unroll
            for (int j = 0; j < 4; ++j) s += (v[rr][j][0] * v[rr][j][0] + v[rr][j][1] * v[rr][j][1]) + (v[rr][j][2] * v[rr][j][2] + v[rr][j][3] * v[rr][j][3]);
            sq[rr] = s; }
#pragma unroll
        for (int o = 1; o < 64; o <<= 1) {
#pragma unroll
            for (int rr = 0; rr < 4; ++rr) sq[rr] += __shfl_xor(sq[rr], o); }
#pragma unroll
        for (int rr = 0; rr < 4; ++rr) { u32x2* o8 = (u32x2*)(xb + (size_t)(m0 + rr) * DM) + lane;
#pragma unroll
            for (int j = 0; j < 4; ++j) { u32x2 w; w.x = cvtpk(v[rr][j][0], v[rr][j][1]); w.y = cvtpk(v[rr][j][2], v[rr][j][3]); o8[64 * j] = w; }
            if (lane == 0) *(f32x4*)(ss + (size_t)(m0 + rr) * 4) = (f32x4){sq[rr], 0.f, 0.f, 0.f}; }
    }
}

__device__ __forceinline__ void unpack8(const u32x4 p, float (&f)[8]) {
#pragma unroll
    for (int i = 0; i < 4; ++i) { f[2 * i] = __builtin_bit_cast(float, p[i] << 16); f[2 * i + 1] = __builtin_bit_cast(float, p[i] & 0xffff0000u); }
}
__device__ __forceinline__ void pool_in_phase(const bf16_t* __restrict__ hb, const float* __restrict__ ss4, bf16_t* __restrict__ P, int gw, int NGW, int lane) {
    const int NITEMS = (M / 32) * 2;
    for (int it = gw; it < NITEMS; it += NGW) {
        const int chunk = it >> 1, strip = it & 1, t0 = chunk * 32, pos0 = t0 & (SEQ - 1);
        float rs = 0.f;
        if (lane < 48 && pos0 + lane - 16 >= 0) rs = rstd_from(*(const f32x4*)(ss4 + (size_t)(t0 - 16 + lane) * 4));
        const int c0 = strip * 512 + lane * 8, w = 2 << (c0 >> 8);
        float S[8];
#pragma unroll
        for (int e = 0; e < 8; ++e) S[e] = 0.f;
#pragma unroll
        for (int j = 1; j <= 16; ++j) {
            const float rj = __shfl(rs, 16 - j);
            if (j <= w && pos0 - j >= 0) { float f[8]; unpack8(*(const u32x4*)(hb + (size_t)(t0 - j) * DM + c0), f);
#pragma unroll
                for (int e = 0; e < 8; ++e) S[e] += f[e] * rj; }
        }
        for (int ib = 0; ib < 4; ++ib) {
            u32x4 xn[8], xo[8];
#pragma unroll
            for (int k = 0; k < 8; ++k) { const int i = ib * 8 + k, t = t0 + i; const bool has = (pos0 + i >= w);
                xn[k] = *(const u32x4*)(hb + (size_t)t * DM + c0); xo[k] = *(const u32x4*)(hb + (size_t)(has ? t - w : t) * DM + c0); }
#pragma unroll
            for (int k = 0; k < 8; ++k) {
                const int i = ib * 8 + k, t = t0 + i, pos = pos0 + i;
                const float rt = __shfl(rs, 16 + i); float ro = __shfl(rs, 16 + i - w); ro = (pos >= w) ? ro : 0.f;
                float xs[8], f[8]; unpack8(xn[k], xs); unpack8(xo[k], f);
#pragma unroll
                for (int e = 0; e < 8; ++e) { xs[e] *= rt; S[e] += xs[e]; S[e] -= f[e] * ro; }
                const int cnt = (pos + 1 < w) ? pos + 1 : w; const float ic = __builtin_amdgcn_rcpf((float)cnt);
                u32x4 o; o.x = cvtpk(S[0] * ic - xs[0], S[1] * ic - xs[1]); o.y = cvtpk(S[2] * ic - xs[2], S[3] * ic - xs[3]);
                o.z = cvtpk(S[4] * ic - xs[4], S[5] * ic - xs[5]); o.w = cvtpk(S[6] * ic - xs[6], S[7] * ic - xs[7]);
                *(u32x4*)(P + (size_t)t * DM + c0) = o;
            }
        }
    }
}

__device__ __forceinline__ float xchg32(float v, int hi) {
    const unsigned u = __builtin_bit_cast(unsigned, v);
    const auto r = __builtin_amdgcn_permlane32_swap(u, u, false, false);
    return __builtin_bit_cast(float, hi ? r[0] : r[1]);
}
template <bool MASK>
__device__ __forceinline__ void sb_tile(const f32x16& Sx, float& carry, int hi, int qlim, bf16x8 (&pf)[2]) {
    float L[16];
#pragma unroll
    for (int r = 0; r < 16; ++r) {
        const float z = Sx[r];
        const float e = __builtin_amdgcn_exp2f(-__builtin_fabsf(z));
        const float sp = __builtin_fmaf(0.5f, z, __builtin_fmaf(0.5f, __builtin_fabsf(z), __builtin_amdgcn_logf(1.0f + e)));
        if (MASK) { const int kk = 16 * (r >> 3) + 8 * hi + (r & 7); L[r] = (kk < qlim) ? -sp : 0.f; } else L[r] = -sp;
    }
    float suf[16];
    suf[7] = L[7]; suf[15] = L[15];
#pragma unroll
    for (int r = 6; r >= 0; --r) { suf[r] = L[r] + suf[r + 1]; suf[8 + r] = L[8 + r] + suf[9 + r]; }
    const float T0 = suf[0], T1 = suf[8];
    const float T0p = xchg32(T0, hi), T1p = xchg32(T1, hi);
    const float offB = carry + (hi == 0 ? T1p : 0.f);
    const float offA = carry + T1 + T1p + (hi == 0 ? T0p : 0.f);
    float Av[16];
#pragma unroll
    for (int r = 0; r < 16; ++r) {
        const float p = __builtin_amdgcn_exp2f(Sx[r] + (suf[r] + (r < 8 ? offA : offB)));
        if (MASK) { const int kk = 16 * (r >> 3) + 8 * hi + (r & 7); Av[r] = (kk < qlim) ? p : 0.f; } else Av[r] = p;
    }
    carry += (T0 + T1) + (T0p + T1p);
#pragma unroll
    for (int s = 0; s < 2; ++s) { u32x4 w; w.x = cvtpk(Av[8 * s], Av[8 * s + 1]); w.y = cvtpk(Av[8 * s + 2], Av[8 * s + 3]); w.z = cvtpk(Av[8 * s + 4], Av[8 * s + 5]); w.w = cvtpk(Av[8 * s + 6], Av[8 * s + 7]);
        pf[s] = __builtin_bit_cast(bf16x8, w); }
}
__device__ __forceinline__ void attn_phase(const bf16_t* Q, const bf16_t* Kb, const bf16_t* VT, bf16_t* O, LAS unsigned char* lds, int bx, int G, int tid) {
    const int lane = tid & 63, w = __builtin_amdgcn_readfirstlane(tid >> 6);
    const int ql = lane & 31, hi = lane >> 5;
    const int kperm = (ql & 0x13) | ((ql & 4) << 1) | ((ql & 8) >> 1);
    constexpr float THR = -110.0f * LOG2E;
    constexpr int NITEMS = NB * NH * (SEQ / 256);
    const int per = (NITEMS + G - 1) / G;
    const int it_end = (bx + 1) * per < NITEMS ? (bx + 1) * per : NITEMS;
    for (int it = bx * per; it < it_end; ++it) {
        const int bh = it >> 5, qblk = it & 31, b = bh >> 4, h = bh & 15;
        const int win0 = qblk * 256 - 256;
        __syncthreads();
        {
#pragma unroll
            for (int i = 0; i < 8; ++i) {
                const int slot = w * 64 + i * 8 + (lane >> 3), c = (lane & 7) ^ ((slot >> 1) & 7);
                int kpos = win0 + slot; kpos = kpos < 0 ? 0 : kpos;
                __builtin_amdgcn_global_load_lds((const unsigned*)(Kb + ((size_t)b * SEQ + kpos) * DM + h * 64 + c * 8), (LAS unsigned*)(lds + (w * 64 + i * 8) * 128), 16, 0, 0);
            }
#pragma unroll
            for (int i = 0; i < 8; ++i) {
                const int d = w * 8 + i, kc = lane ^ (d & 15);
                int kpos = win0 + 8 * kc; kpos = kpos < 0 ? 0 : kpos;
                __builtin_amdgcn_global_load_lds((const unsigned*)(VT + (size_t)(h * 64 + d) * M + (size_t)b * SEQ + kpos), (LAS unsigned*)(lds + 65536 + d * 1024), 16, 0, 0);
            }
        }
        const int qb = qblk * 8 + w;
        const size_t tok0 = (size_t)b * SEQ + (size_t)qb * 32;
        const bf16_t* qptr = Q + (tok0 + ql) * DM + h * 64 + 8 * hi;
        bf16x8 qf[4];
#pragma unroll
        for (int ks = 0; ks < 4; ++ks) qf[ks] = *(const bf16x8*)(qptr + 16 * ks);
        asm volatile("s_waitcnt vmcnt(0)" ::: "memory");
        __syncthreads();
        f32x16 o0, o1;
#pragma unroll
        for (int r = 0; r < 16; ++r) { o0[r] = 0.f; o1[r] = 0.f; }
        float carry = 0.f;
        const bf16_t* kbase = Kb + ((size_t)b * SEQ + kperm) * DM + h * 64 + 8 * hi;
        const bf16_t* vbase = VT + (size_t)(h * 64 + ql) * M + (size_t)b * SEQ + 8 * hi;
        for (int kt = qb; kt >= 0; --kt) {
            bf16x8 kf[4], vf[2][2];
            const int kr = kt * 32 - win0;
            if (kr >= 0) {
                const int ksl = kr + kperm, sw = (ksl >> 1) & 7;
                const LAS unsigned char* kl = lds + ksl * 128;
#pragma unroll
                for (int ks = 0; ks < 4; ++ks) kf[ks] = *(const LAS bf16x8*)(kl + (((2 * ks + hi) ^ sw) << 4));
                const int kc0 = (kr >> 3) + hi;
#pragma unroll
                for (int dh = 0; dh < 2; ++dh)
#pragma unroll
                    for (int s = 0; s < 2; ++s) vf[dh][s] = *(const LAS bf16x8*)(lds + 65536 + (dh * 32 + ql) * 1024 + (((kc0 + 2 * s) ^ (ql & 15)) << 4));
            } else {
                const bf16_t* kp = kbase + (size_t)kt * 32 * DM; const bf16_t* vp = vbase + kt * 32;
#pragma unroll
                for (int ks = 0; ks < 4; ++ks) kf[ks] = *(const bf16x8*)(kp + 16 * ks);
#pragma unroll
                for (int dh = 0; dh < 2; ++dh)
#pragma unroll
                    for (int s = 0; s < 2; ++s) vf[dh][s] = *(const bf16x8*)(vp + (size_t)dh * 32 * M + 16 * s);
            }
            f32x16 Sx;
#pragma unroll
            for (int r = 0; r < 16; ++r) Sx[r] = 0.f;
#pragma unroll
            for (int ks = 0; ks < 4; ++ks) Sx = __builtin_amdgcn_mfma_f32_32x32x16_bf16(kf[ks], qf[ks], Sx, 0, 0, 0);
            bf16x8 pf[2];
            if (kt == qb) sb_tile<true>(Sx, carry, hi, ql, pf); else sb_tile<false>(Sx, carry, hi, 0, pf);
#pragma unroll
            for (int s = 0; s < 2; ++s) { o0 = __builtin_amdgcn_mfma_f32_32x32x16_bf16(vf[0][s], pf[s], o0, 0, 0, 0); o1 = __builtin_amdgcn_mfma_f32_32x32x16_bf16(vf[1][s], pf[s], o1, 0, 0, 0); }
            if (__ballot(carry > THR) == 0ull) break;
        }
        bf16_t* op = O + (tok0 + ql) * DM + h * 64 + 4 * hi;
#pragma unroll
        for (int r4 = 0; r4 < 4; ++r4) {
            u32x2 w0; w0.x = cvtpk(o0[4 * r4], o0[4 * r4 + 1]); w0.y = cvtpk(o0[4 * r4 + 2], o0[4 * r4 + 3]);
            u32x2 w1; w1.x = cvtpk(o1[4 * r4], o1[4 * r4 + 1]); w1.y = cvtpk(o1[4 * r4 + 2], o1[4 * r4 + 3]);
            *(u32x2*)(op + 8 * r4) = w0; *(u32x2*)(op + 32 + 8 * r4) = w1;
        }
    }
    __syncthreads();
}

#define XB_TMO      128
#define XB_XCNT(j)  (256  + 64 * (j))
#define XB_XSUB(j)  (1280 + 64 * (j))
#define XB_XGEN(j)  (2304 + 64 * (j))
#define XB_TOP      3328
#define XB_TOPGEN   3392
#define XCD_BAR_WORDS 3456
#define XB_SPIN_CAP (1u << 18)

__device__ __forceinline__ unsigned xb_ld(unsigned* p)              { return __hip_atomic_load(p, __ATOMIC_RELAXED, __HIP_MEMORY_SCOPE_AGENT); }
__device__ __forceinline__ unsigned xb_add(unsigned* p, unsigned v) { return __hip_atomic_fetch_add(p, v, __ATOMIC_RELAXED, __HIP_MEMORY_SCOPE_AGENT); }
__device__ __forceinline__ unsigned xb_xcc_id() { return (unsigned)__builtin_amdgcn_s_getreg((3 << 11) | 20) & 0xFu; }
#define XB_SPIN(cond, bar) do { unsigned _sp = 0; while (cond) { __builtin_amdgcn_s_sleep(1); \
    if ((++_sp & 255u) == 0u) { if (xb_ld(&(bar)[XB_TMO])) break; if (_sp > XB_SPIN_CAP) { atomicAdd(&(bar)[XB_TMO], 1u); break; } } } } while (0)

struct XcdBarrier {
    unsigned* bar; unsigned x;
    volatile LAS unsigned* st;
};

__device__ __forceinline__ XcdBarrier xcd_barrier_post(unsigned* bar, volatile LAS unsigned* st) {
    XcdBarrier b; b.bar = bar; b.x = xb_xcc_id(); b.st = st;
    if (threadIdx.x == 0) (void)xb_add(&bar[XB_XCNT(b.x)], 1u);
    return b;
}
__device__ __forceinline__ void xcd_barrier_complete(unsigned* bar, unsigned x, unsigned& nloc, unsigned& nx) {
    const unsigned G = gridDim.x * gridDim.y * gridDim.z;
    unsigned sum, cnt, mine, sp = 0u;
    for (;;) {
        sum = 0u; cnt = 0u; mine = 0u;
#pragma unroll
        for (unsigned j = 0; j < 16; ++j) { const unsigned c = xb_ld(&bar[XB_XCNT(j)]); sum += c; cnt += (c > 0u) ? 1u : 0u; mine = (j == x) ? c : mine; }
        if (sum == G) break;
        __builtin_amdgcn_s_sleep(1);
        if ((++sp & 255u) == 0u) { if (xb_ld(&bar[XB_TMO])) break; if (sp > XB_SPIN_CAP) { atomicAdd(&bar[XB_TMO], 1u); break; } }
    }
    nloc = mine > 0u ? mine : 1u; nx = cnt > 0u ? cnt : 1u;
}

__device__ __forceinline__ void xcd_barrier(const XcdBarrier& b) {
    asm volatile("s_waitcnt vmcnt(0)" ::: "memory");
    __syncthreads();
    if (threadIdx.x == 0) {
        unsigned* bar = b.bar;
        __builtin_amdgcn_s_waitcnt(0);
        unsigned nloc = b.st[0], nx = b.st[1];
        if (nloc == 0u) { xcd_barrier_complete(bar, b.x, nloc, nx); b.st[0] = nloc; b.st[1] = nx; }
        const unsigned old = xb_add(&bar[XB_XSUB(b.x)], 1u);
        const unsigned gen = old / nloc;
        if (old + 1u == (gen + 1u) * nloc) {
            __builtin_amdgcn_fence(__ATOMIC_RELEASE, "agent");
            asm volatile("s_waitcnt vmcnt(0)" ::: "memory");
            const unsigned og = xb_add(&bar[XB_TOP], 1u);
            const unsigned tg = og / nx;
            if (og + 1u == (tg + 1u) * nx) xb_add(&bar[XB_TOPGEN], 1u);
            else XB_SPIN(xb_ld(&bar[XB_TOPGEN]) == tg, bar);
            __builtin_amdgcn_fence(__ATOMIC_ACQUIRE, "agent");
            xb_add(&bar[XB_XGEN(b.x)], 1u);
            asm volatile("s_waitcnt vmcnt(0)" ::: "memory");
        } else {
            XB_SPIN(xb_ld(&bar[XB_XGEN(b.x)]) == gen, bar);
            __builtin_amdgcn_fence(__ATOMIC_ACQUIRE, "agent");
            asm volatile("s_waitcnt vmcnt(0)" ::: "memory");
        }
    }
    __syncthreads();
}

constexpr int NSTEPS = 16;
__global__ void __launch_bounds__(512, 2) yoco_fwd(Args a_unused) {
    extern __shared__ __attribute__((aligned(16))) unsigned char lds_raw[];
    LAS unsigned char* lds = (LAS unsigned char*)lds_raw;
    const int st_lo = get_args()->st_lo, st_hi = get_args()->st_hi;
    volatile LAS unsigned* MISC = (volatile LAS unsigned*)(lds + RING_BYTES + 4096);
    if (threadIdx.x < 8) MISC[threadIdx.x] = 0u;
    __syncthreads();
    if (st_hi - st_lo > 1 && blockIdx.x == 0) {
        unsigned* bw = (unsigned*)(get_args()->ws + WS_BAR);
        for (int i = threadIdx.x; i < XCD_BAR_WORDS; i += 512) bw[i] = 0u;
    }
    for (int sti = st_lo; sti < st_hi; ++sti) {
        const int st = (sti <= MK_REP) ? sti : sti - 1;
        KArgs ap = get_args();
        unsigned char* ws = ap->ws;
        int tid = threadIdx.x; asm volatile("" : "+v"(tid));
        const int lane = tid & 63, wave = __builtin_amdgcn_readfirstlane(tid >> 6);
        const int G = gridDim.x, bx = blockIdx.x;
        const int gw = bx * 8 + wave, NGW = G * 8;
        if (st == 0) {
            prep_phase(ap, lds, gw, NGW, wave, lane);
        } else if (st == 3) {
            pool_in_phase((const bf16_t*)(ws + WS_HBB), (const float*)(ws + WS_SSB), (bf16_t*)(ws + WS_HBA), gw, NGW, lane);
        } else if (st == 12) {
            attn_phase((const bf16_t*)(ws + WS_HBB), (const bf16_t*)(ws + WS_K), (const bf16_t*)(ws + WS_VT), (bf16_t*)(ws + WS_HID), lds, bx, G, tid);
        } else if (st == 1 || st == 5 || st == 9 || st == 14) {
            const int f = (st == 1) ? 0 : (st == 5) ? 1 : (st == 9) ? 2 : 3;
            const bool useA = (st == 1 || st == 5);
            pg8::Gemm g{(const bf16_t*)(ws + (useA ? WS_HBA : WS_HBB)), (const bf16_t*)(ws + WS_WIN + f * WIN_BYTES), DM, DM, DM, 0};
            pg8::StaticOrder S; S.init(M / 256, NIN / 256, G, bx); S.mode = 1;
            pg8::EpiSwiGLU E{(bf16_t*)(ws + WS_HID), (const float*)(ws + (useA ? WS_SSA : WS_SSB))};
            pg8::gemm_phase(lds, g, S, E, tid);
        } else if (st == 7 || st == 11) {
            const bool isK = (st == 7);
            pg8::Gemm g{(const bf16_t*)(ws + (isK ? WS_HBB : WS_HBA)), (const bf16_t*)(ws + (isK ? WS_WK : WS_WQ)), DM, DM, DM, 0};
            pg8::StaticOrder S; S.init(M / 256, DM / 256, G, bx); S.mode = 3;
            pg8::EpiHeadNorm E{(bf16_t*)(ws + (isK ? WS_K : WS_HBB)), (const float*)(ws + (isK ? WS_SSB : WS_SSA)), ap->in[isK ? 12 : 15], isK ? 1.0f : 0.125f * LOG2E};
            pg8::gemm_phase(lds, g, S, E, tid);
        } else if (st == 8) {
            pg8::Gemm g{(const bf16_t*)(ws + WS_WV), (const bf16_t*)(ws + WS_HBB), DM, DM, DM, 0};
            pg8::StaticOrder S; S.init(DM / 256, M / 256, G, bx); S.mode = 4;
            pg8::EpiVT E{(bf16_t*)(ws + WS_VT), (const float*)(ws + WS_SSB)};
            pg8::gemm_phase(lds, g, S, E, tid);
        } else {
            const bool isP = (st == 4), isO = (st == 13), isF = !(isP || isO);
            const int f = (st == 2) ? 0 : (st == 6) ? 1 : (st == 10) ? 2 : 3;
            const bf16_t* gA = (const bf16_t*)(ws + ((isF || isO) ? WS_HID : WS_HBA));
            const bf16_t* gB = (const bf16_t*)(ws + (isP ? WS_WP : isO ? WS_WO : WS_WOUT + f * WOUT_BYTES));
            const int lda = isF ? FF : DM, ldb = isP ? 256 : isO ? DM : FF;
            pg8::Gemm g{gA, gB, lda, ldb, ldb, isP ? 512 : 0};
            const bool toA = (st == 4 || st == 10);
            pg8::StaticOrder S; S.init(M / 256, DM / 256, G, bx); S.mode = 3;
            const bf16_t* resp = (const bf16_t*)(ws + ((toA || st == 15) ? WS_HBB : WS_HBA));
            if (st == 15) { pg8::EpiRes<true> E{resp, nullptr, ap->out, nullptr}; pg8::gemm_phase(lds, g, S, E, tid); }
            else { pg8::EpiRes<false> E{resp, (bf16_t*)(ws + (toA ? WS_HBA : WS_HBB)), nullptr, (float*)(ws + (toA ? WS_SSA : WS_SSB))}; pg8::gemm_phase(lds, g, S, E, tid); }
        }
        if (sti + 1 < st_hi && st != 7 && st != 8) {
            if (sti == st_lo) { cg::this_grid().sync(); (void)xcd_barrier_post((unsigned*)(ws + WS_BAR), MISC); }
            else { XcdBarrier xb; xb.bar = (unsigned*)(ws + WS_BAR); xb.x = xb_xcc_id(); xb.st = MISC; xcd_barrier(xb); }
        }
    }
}

extern "C" void kernel_launch(void* const* d_in, const int* in_sizes, int n_in, void* d_out, int out_size, void* d_ws, size_t ws_size, hipStream_t stream) {
    static int grid = 0;
    if (grid == 0) {
        if (n_in != 17 || out_size != M * DM || ws_size < WS_END) { fprintf(stderr, "kernel_launch: unexpected shapes (n_in %d out %d ws %zu)\n", n_in, out_size, ws_size); grid = -1; return; }
        int dev = 0, cus = 0, per_cu = 0;
        hipGetDevice(&dev);
        hipDeviceGetAttribute(&cus, hipDeviceAttributeMultiprocessorCount, dev);
        hipFuncSetAttribute((const void*)yoco_fwd, hipFuncAttributeMaxDynamicSharedMemorySize, LDS_BYTES);
        hipOccupancyMaxActiveBlocksPerMultiprocessor(&per_cu, (const void*)yoco_fwd, 512, LDS_BYTES);
        (void)hipGetLastError();
        if (per_cu < 1) per_cu = 1;
        grid = cus * per_cu;
    }
    if (grid < 0) return;
    Args a{};
    for (int i = 0; i < 17; ++i) a.in[i] = (const float*)d_in[i];
    a.out = (float*)d_out; a.ws = (unsigned char*)d_ws;
#if MK_SINGLE
    a.st_lo = 0; a.st_hi = NSTEPS + (MK_REP < NSTEPS ? 1 : 0);
    void* args[] = {&a};
    hipError_t e = hipLaunchCooperativeKernel((const void*)yoco_fwd, dim3(grid), dim3(512), args, LDS_BYTES, stream);
    if (e != hipSuccess) fprintf(stderr, "cooperative launch failed: %s (grid %d)\n", hipGetErrorString(e), grid);
#else
    for (int st = 0; st < NSTEPS; ++st) {
        a.st_lo = st; a.st_hi = st + 1;
        hipLaunchKernelGGL(yoco_fwd, dim3(grid), dim3(512), LDS_BYTES, stream, a);
    }
#endif
}
```
